# Optimizing an MI355X kernel written in HIP

```python
import math
import jax, jax.numpy as jnp
from jax import lax
import numpy as np

D_MODEL = 2048
BATCH = 8
SEQ = 2048
DEPTH = 1

GRID_W = 64
NA_HEADS = 8
NA_HEAD_DIM = 128
NA_WIN_ROWS = 8
NA_WIN_COLS = 16
NA_WIDTH = NA_HEADS * NA_HEAD_DIM
MLA_HEADS = 8
MLA_Q_RANK = 512
MLA_KV_RANK = 512
MLA_NOPE_DIM = 128
MLA_ROPE_DIM = 64
MLA_V_DIM = 128
MLA_QK_DIM = MLA_NOPE_DIM + MLA_ROPE_DIM
MLA_WIDTH = MLA_HEADS * MLA_V_DIM
ROPE_THETA = 10000.0
Q_BLOCK = 128
D_FF = 5632
PL_DIM = 256
NORM_EPS = 1e-6
NEG_INF = -1e30
IN_SIZES = (NA_WIDTH, NA_WIDTH, NA_WIDTH, MLA_Q_RANK, MLA_KV_RANK, MLA_ROPE_DIM, D_MODEL, D_MODEL)
N_IN = NA_WIDTH * 3 + MLA_Q_RANK + MLA_KV_RANK + MLA_ROPE_DIM + 2 * D_MODEL

kernel_name = "hybrid_na2d_mla_macaron_encoder"


def rmsnorm(x, g):
    xf = x.astype(jnp.float32)
    y = xf * lax.rsqrt(jnp.mean(xf * xf, axis=-1, keepdims=True) + NORM_EPS)
    return (y * g.astype(jnp.float32)).astype(x.dtype)


def swiglu(x, w_gate, w_up, w_down):
    return (jax.nn.silu(x @ w_gate) * (x @ w_up)) @ w_down


def split_points():
    pts, acc = [], 0
    for s in IN_SIZES[:-1]:
        acc += s
        pts.append(acc)
    return pts


def rope_tables(seq_len, dim):
    pos = jnp.arange(seq_len, dtype=jnp.float32)
    inv_freq = 1.0 / (ROPE_THETA ** (jnp.arange(0, dim, 2, dtype=jnp.float32) / dim))
    ang = pos[:, None] * inv_freq[None, :]
    return jnp.cos(ang), jnp.sin(ang)


def apply_rope(x, cos, sin):
    half = x.shape[-1] // 2
    x1, x2 = x[..., :half], x[..., half:]
    cos = cos.astype(x.dtype)
    sin = sin.astype(x.dtype)
    return jnp.concatenate([x1 * cos - x2 * sin, x2 * cos + x1 * sin], axis=-1)


def neighbourhood_attention(q, k, v, rpb):
    B, S, _ = q.shape
    rows = S // GRID_W
    kh = min(NA_WIN_ROWS, rows)
    kw = NA_WIN_COLS
    grid = lambda t: t.reshape(B, rows, GRID_W, NA_HEADS, NA_HEAD_DIM)
    qg, kg, vg = grid(q), grid(k), grid(v)
    cols = np.arange(GRID_W)
    col_start = np.clip(cols - kw // 2, 0, GRID_W - kw)
    col_mask = (cols[None, :] >= col_start[:, None]) & (cols[None, :] < col_start[:, None] + kw)
    dc_idx = np.clip(cols[None, :] - cols[:, None], -(kw - 1), kw - 1) + (kw - 1)
    col_mask = jnp.asarray(col_mask)[:, None, :]
    dc_idx = jnp.asarray(dc_idx)
    scale = NA_HEAD_DIM ** -0.5

    def row_block(args):
        q_row, r = args
        rs = jnp.clip(r - kh // 2, 0, rows - kh)
        k_rows = lax.dynamic_slice_in_dim(kg, rs, kh, axis=1)
        v_rows = lax.dynamic_slice_in_dim(vg, rs, kh, axis=1)
        dr = rs + jnp.arange(kh) - r
        bias = rpb[:, dr + (NA_WIN_ROWS - 1)][:, :, dc_idx]
        bias = bias.transpose(0, 2, 1, 3).astype(jnp.float32)
        s = jnp.einsum('bqhd,bikhd->bhqik', q_row, k_rows).astype(jnp.float32) * scale + bias
        s = jnp.where(col_mask, s, NEG_INF)
        pr = jax.nn.softmax(s.reshape(B, NA_HEADS, GRID_W, kh * GRID_W), axis=-1)
        pr = pr.reshape(s.shape).astype(v.dtype)
        return jnp.einsum('bhqik,bikhd->bqhd', pr, v_rows)

    o = lax.map(row_block, (qg.swapaxes(0, 1), jnp.arange(rows)))
    return o.swapaxes(0, 1).reshape(B, S, NA_WIDTH)


def mla_attention(q_lat, kv_lat, k_rope_in, q_a_norm, w_uq, kv_a_norm, w_ukv):
    B, S, _ = q_lat.shape
    cq = rmsnorm(q_lat, q_a_norm)
    q = (cq @ w_uq).reshape(B, S, MLA_HEADS, MLA_QK_DIM)
    q_nope, q_rope = q[..., :MLA_NOPE_DIM], q[..., MLA_NOPE_DIM:]
    ckv = rmsnorm(kv_lat, kv_a_norm)
    kv = (ckv @ w_ukv).reshape(B, S, MLA_HEADS, MLA_NOPE_DIM + MLA_V_DIM)
    k_nope, v = kv[..., :MLA_NOPE_DIM], kv[..., MLA_NOPE_DIM:]
    cos, sin = rope_tables(S, MLA_ROPE_DIM)
    q_rope = apply_rope(q_rope, cos[:, None, :], sin[:, None, :])
    k_rope = apply_rope(k_rope_in, cos, sin)
    scale = MLA_QK_DIM ** -0.5
    nb = S // Q_BLOCK
    to_blocks = lambda t: t.reshape(B, nb, Q_BLOCK, *t.shape[2:]).swapaxes(0, 1)

    def q_block(args):
        qn, qr = args
        s = jnp.einsum('bqhd,bkhd->bhqk', qn, k_nope) + jnp.einsum('bqhr,bkr->bhqk', qr, k_rope)
        pr = jax.nn.softmax(s.astype(jnp.float32) * scale, axis=-1).astype(v.dtype)
        return jnp.einsum('bhqk,bkhd->bqhd', pr, v)

    o = lax.map(q_block, (to_blocks(q_nope), to_blocks(q_rope)))
    return o.swapaxes(0, 1).reshape(B, S, MLA_WIDTH)


def setup_inputs(seed: int = 0) -> dict:
    key = jax.random.key(seed)
    ks = iter(jax.random.split(key, 32))
    f32 = jnp.float32
    w = lambda shape, fan_in: jax.random.normal(next(ks), shape, f32) * (fan_in ** -0.5)
    gain = lambda shape: 1.0 + 0.01 * jax.random.normal(next(ks), shape, f32)
    L = DEPTH
    return {
        "x": jax.random.normal(next(ks), (BATCH, SEQ, D_MODEL), f32),
        "p": jax.random.normal(next(ks), (DEPTH, BATCH, SEQ, PL_DIM), f32),
        "ffn1_norm": gain((L, D_MODEL)),
        "ffn1_w_gate": w((L, D_MODEL, D_FF), D_MODEL),
        "ffn1_w_up": w((L, D_MODEL, D_FF), D_MODEL),
        "ffn1_w_down": w((L, D_FF, D_MODEL), D_FF),
        "mix_norm": gain((L, D_MODEL)),
        "w_in": w((L, D_MODEL, N_IN), D_MODEL),
        "q_a_norm": gain((L, MLA_Q_RANK)),
        "w_uq": w((L, MLA_Q_RANK, MLA_HEADS * MLA_QK_DIM), MLA_Q_RANK),
        "kv_a_norm": gain((L, MLA_KV_RANK)),
        "w_ukv": w((L, MLA_KV_RANK, MLA_HEADS * (MLA_NOPE_DIM + MLA_V_DIM)), MLA_KV_RANK),
        "na_rpb": 0.02 * jax.random.normal(next(ks), (L, NA_HEADS, 2 * NA_WIN_ROWS - 1, 2 * NA_WIN_COLS - 1), f32),
        "w_branch_a": w((L, NA_WIDTH, D_MODEL), NA_WIDTH),
        "w_branch_b": w((L, MLA_WIDTH, D_MODEL), MLA_WIDTH),
        "w_out": w((L, D_MODEL, D_MODEL), D_MODEL),
        "ffn2_norm": gain((L, D_MODEL)),
        "ffn2_w_gate": w((L, D_MODEL, D_FF), D_MODEL),
        "ffn2_w_up": w((L, D_MODEL, D_FF), D_MODEL),
        "ffn2_w_down": w((L, D_FF, D_MODEL), D_FF),
        "pl_norm": gain((L, D_MODEL)),
        "w_pl": w((L, PL_DIM, D_MODEL), PL_DIM),
        "w_pl_gate": w((L, D_MODEL, D_MODEL), D_MODEL),
        "final_norm": gain((D_MODEL,)),
    }


def reference(x, p, ffn1_norm, ffn1_w_gate, ffn1_w_up, ffn1_w_down, mix_norm, w_in,
              q_a_norm, w_uq, kv_a_norm, w_ukv, na_rpb, w_branch_a, w_branch_b, w_out,
              ffn2_norm, ffn2_w_gate, ffn2_w_up, ffn2_w_down, pl_norm, w_pl, w_pl_gate,
              final_norm):
    pts = split_points()
    h = x
    for i in range(DEPTH):
        h = h + 0.5 * swiglu(rmsnorm(h, ffn1_norm[i]), ffn1_w_gate[i], ffn1_w_up[i], ffn1_w_down[i])
        u = rmsnorm(h, mix_norm[i])
        z = u @ w_in[i]
        na_q, na_k, na_v, q_lat, kv_lat, k_rope, gate_a, gate_b = jnp.split(z, pts, axis=-1)
        y_a = neighbourhood_attention(na_q, na_k, na_v, na_rpb[i]) @ w_branch_a[i]
        y_b = mla_attention(q_lat, kv_lat, k_rope, q_a_norm[i], w_uq[i], kv_a_norm[i], w_ukv[i]) @ w_branch_b[i]
        merged = jax.nn.sigmoid(gate_a) * y_a + jax.nn.sigmoid(gate_b) * y_b
        h = h + merged @ w_out[i]
        h = h + 0.5 * swiglu(rmsnorm(h, ffn2_norm[i]), ffn2_w_gate[i], ffn2_w_up[i], ffn2_w_down[i])
        pl_gate = jax.nn.sigmoid(rmsnorm(h, pl_norm[i]) @ w_pl_gate[i])
        h = h + pl_gate * (p[i] @ w_pl[i])
    return rmsnorm(h, final_norm)
```

```cpp
#include <hip/hip_runtime.h>
#include <hip/hip_cooperative_groups.h>
#include <cstdio>
#include <cstdint>
namespace cg = cooperative_groups;

#ifndef MEGA
#define MEGA 1
#endif

#define LAS __attribute__((address_space(3)))
typedef unsigned short bf16_t;
typedef short bf16x8 __attribute__((ext_vector_type(8)));
typedef short s16x4 __attribute__((ext_vector_type(4)));
typedef float f32x4 __attribute__((ext_vector_type(4)));
typedef float f32x16 __attribute__((ext_vector_type(16)));
typedef unsigned u32x4 __attribute__((ext_vector_type(4)));
typedef unsigned u32x2 __attribute__((ext_vector_type(2)));

constexpr int T = 16384, DM = 2048, DFF = 5632, SEQ = 2048;
constexpr int LDHB = 2368;
constexpr float EPS = 1e-6f;
constexpr int LDACT = 5696, LDWD = 5696;
constexpr int LDB2K = 2112;

constexpr size_t SZ_WUQ = 1536ull * 512 * 2, SZ_WUKV = 2048ull * 512 * 2, SZ_WAB = 2048ull * LDB2K * 2, SZ_WOUT = SZ_WAB, SZ_WPL = 2048ull * 2304 * 2;
constexpr size_t OFF_WUQ = 0, OFF_WUKV = OFF_WUQ + SZ_WUQ, OFF_WAB = OFF_WUKV + SZ_WUKV, OFF_WOUT = OFF_WAB + SZ_WAB, OFF_WPL = OFF_WOUT + SZ_WOUT;
constexpr size_t OFF_HB = OFF_WPL + SZ_WPL, SZ_HB = (size_t)T * LDHB * 2;
constexpr size_t OFF_C = OFF_HB + SZ_HB, SZ_C = (size_t)T * LDACT * 2;
constexpr size_t OFF_ACT = OFF_C, OFF_QKV = OFF_C, OFF_LAT = OFF_C + (size_t)T * 3072 * 2, OFF_GATES = OFF_C, OFF_Q = OFF_C + (size_t)T * 4096 * 2, OFF_ETMP = OFF_C;
constexpr size_t OFF_KV = OFF_C + SZ_C, OFF_MERGED = OFF_KV, OFF_ATT = OFF_KV + (size_t)T * 2048 * 2, OFF_KROPE = OFF_ATT + (size_t)T * 2048 * 2;
constexpr size_t OFF_WGU = OFF_KROPE + (size_t)T * 64 * 2, SZ_WGU = 11264ull * LDB2K * 2, OFF_WD = OFF_WGU + SZ_WGU, SZ_WD = 2048ull * LDWD * 2;
constexpr size_t OFF_WIN = OFF_WD + SZ_WD, SZ_WIN = 8448ull * LDB2K * 2;
constexpr size_t SZ_PART = (size_t)T * 32 * 4;
constexpr size_t OFF_PART0 = OFF_WIN + SZ_WIN, OFF_LATPART = OFF_PART0 + 5 * SZ_PART, OFF_ROPEC = OFF_LATPART + (size_t)T * 16 * 4, OFF_ROPES = OFF_ROPEC + 2048 * 32 * 4;
constexpr size_t OFF_BAR = OFF_ROPES + 2048 * 32 * 4, SZ_BAR = 16384;
constexpr size_t WS_END = OFF_BAR + SZ_BAR;
static_assert(WS_END <= 555280928ull, "workspace overflow");
static_assert(OFF_Q + (size_t)T * 1536 * 2 <= OFF_C + SZ_C, "q overlay");

struct Params {
    const float *x, *p, *ffn1_norm, *ffn1_wg, *ffn1_wu, *ffn1_wd, *mix_norm, *w_in, *q_a_norm, *w_uq, *kv_a_norm, *w_ukv, *na_rpb, *w_a, *w_b, *w_out,
        *ffn2_norm, *ffn2_wg, *ffn2_wu, *ffn2_wd, *pl_norm, *w_pl, *w_plg, *final_norm;
    float* H;
    char* ws;
};

__device__ __forceinline__ int opq_tid() { int t = threadIdx.x; asm volatile("" : "+v"(t)); return t; }
typedef __bf16 bf16x2_t __attribute__((ext_vector_type(2)));
typedef float f32x2_t __attribute__((ext_vector_type(2)));
__device__ __forceinline__ unsigned cvt_pk_bf16(float lo, float hi) { const f32x2_t v = {lo, hi}; const bf16x2_t r = __builtin_convertvector(v, bf16x2_t); return __builtin_bit_cast(unsigned, r); }
__device__ __forceinline__ f32x4 ld_nt(const float* p) { return __builtin_nontemporal_load((const f32x4*)p); }
__device__ __forceinline__ u32x4 ld_nt(const bf16_t* p) { return __builtin_nontemporal_load((const u32x4*)p); }
__device__ __forceinline__ void st_nt(float* p, f32x4 v) { __builtin_nontemporal_store(v, (f32x4*)p); }
__device__ __forceinline__ void st_nt(bf16_t* p, u32x4 v) { __builtin_nontemporal_store(v, (u32x4*)p); }
__device__ __forceinline__ float bf_lo(unsigned w) { return __uint_as_float(w << 16); }
__device__ __forceinline__ float bf_hi(unsigned w) { return __uint_as_float(w & 0xffff0000u); }
__device__ __forceinline__ float sigmoidf_(float v) { return __builtin_amdgcn_rcpf(1.0f + __builtin_amdgcn_exp2f(-1.4426950408889634f * v)); }

struct CvtJob { const float* src; bf16_t* dst; const float* gain; int ldsrc, Ks, Ns, Kd, koff, mode, param; };
__device__ __forceinline__ int map_col(int mode, int param, int n) {
    if (mode == 0) return n + param;
    if (mode == 1) return (n >> 7) * 256 + (n & 127) + param;
    if (mode == 2) { const int h = n / 192, o = n - h * 192; if (o < 128) return n; const int i = o - 128; return h * 192 + 128 + 8 * ((i & 31) >> 2) + 4 * (i >> 5) + (i & 3); }
    if (n < 4096) return n;
    if (n < 4160) { const int i = n - 4096; return 8192 + 8 * ((i & 31) >> 2) + 4 * (i >> 5) + (i & 3); }
    { const int g = n - 4160; const int isb = g >= 2048 ? 1 : 0; const int c = g - isb * 2048; return 4096 + (c >> 7) * 256 + isb * 128 + (c & 127); }
}
__device__ __forceinline__ CvtJob get_job(const Params& P, int j) {
    CvtJob J; J.gain = nullptr; J.koff = 0; J.mode = 0; J.param = 0;
    char* ws = P.ws;
    switch (j) {
    case 0: J.src = P.ffn1_wg; J.dst = (bf16_t*)(ws + OFF_WGU); J.gain = P.ffn1_norm; J.ldsrc = 5632; J.Ks = 2048; J.Ns = 5632; J.Kd = LDB2K; J.mode = 1; J.param = 0; break;
    case 1: J.src = P.ffn1_wu; J.dst = (bf16_t*)(ws + OFF_WGU); J.gain = P.ffn1_norm; J.ldsrc = 5632; J.Ks = 2048; J.Ns = 5632; J.Kd = LDB2K; J.mode = 1; J.param = 128; break;
    case 2: J.src = P.ffn1_wd; J.dst = (bf16_t*)(ws + OFF_WD); J.ldsrc = 2048; J.Ks = 5632; J.Ns = 2048; J.Kd = LDWD; break;
    case 3: J.src = P.w_in; J.dst = (bf16_t*)(ws + OFF_WIN); J.gain = P.mix_norm; J.ldsrc = 8256; J.Ks = 2048; J.Ns = 8256; J.Kd = LDB2K; J.mode = 3; break;
    case 4: J.src = P.w_uq; J.dst = (bf16_t*)(ws + OFF_WUQ); J.gain = P.q_a_norm; J.ldsrc = 1536; J.Ks = 512; J.Ns = 1536; J.Kd = 512; J.mode = 2; break;
    case 5: J.src = P.w_ukv; J.dst = (bf16_t*)(ws + OFF_WUKV); J.gain = P.kv_a_norm; J.ldsrc = 2048; J.Ks = 512; J.Ns = 2048; J.Kd = 512; break;
    case 6: J.src = P.w_a; J.dst = (bf16_t*)(ws + OFF_WAB); J.ldsrc = 2048; J.Ks = 1024; J.Ns = 2048; J.Kd = LDB2K; break;
    case 7: J.src = P.w_b; J.dst = (bf16_t*)(ws + OFF_WAB); J.ldsrc = 2048; J.Ks = 1024; J.Ns = 2048; J.Kd = LDB2K; J.koff = 1024; break;
    case 8: J.src = P.w_out; J.dst = (bf16_t*)(ws + OFF_WOUT); J.ldsrc = 2048; J.Ks = 2048; J.Ns = 2048; J.Kd = LDB2K; break;
    case 9: J.src = P.w_pl; J.dst = (bf16_t*)(ws + OFF_WPL); J.ldsrc = 2048; J.Ks = 256; J.Ns = 2048; J.Kd = 2304; break;
    case 10: J.src = P.w_plg; J.dst = (bf16_t*)(ws + OFF_WPL); J.gain = P.pl_norm; J.ldsrc = 2048; J.Ks = 2048; J.Ns = 2048; J.Kd = 2304; J.koff = 256; break;
    case 11: J.src = P.ffn2_wg; J.dst = (bf16_t*)(ws + OFF_WGU); J.gain = P.ffn2_norm; J.ldsrc = 5632; J.Ks = 2048; J.Ns = 5632; J.Kd = LDB2K; J.mode = 1; J.param = 0; break;
    case 12: J.src = P.ffn2_wu; J.dst = (bf16_t*)(ws + OFF_WGU); J.gain = P.ffn2_norm; J.ldsrc = 5632; J.Ks = 2048; J.Ns = 5632; J.Kd = LDB2K; J.mode = 1; J.param = 128; break;
    default: J.src = P.ffn2_wd; J.dst = (bf16_t*)(ws + OFF_WD); J.ldsrc = 2048; J.Ks = 5632; J.Ns = 2048; J.Kd = LDWD; break;
    }
    return J;
}
constexpr int CVT_LDW = 130;
__device__ __forceinline__ void convert_job(const CvtJob& J, int& base, char* lds) {
    unsigned* s = (unsigned*)lds;
    const int tid = opq_tid();
    {
        const int ntn = J.Ns >> 6, ntk = J.Ks >> 8, nt = ntn * ntk;
        const int first = ((int)blockIdx.x - base % (int)gridDim.x + (int)gridDim.x) % (int)gridDim.x;
        const int lk2 = tid >> 4, ln = (tid & 15) << 2;
        for (int t = first; t < nt; t += 2 * gridDim.x) {
            const int t1 = t + gridDim.x; const bool two = t1 < nt;
            const int tk0 = t / ntn, tn0 = t - tk0 * ntn, ka = tk0 << 8, na = tn0 << 6;
            const int tk1 = two ? t1 / ntn : tk0, tn1 = two ? t1 - tk1 * ntn : tn0, kb = tk1 << 8, nb = tn1 << 6;
            f32x4 va[4][2], vb[4][2];
#pragma unroll
            for (int i = 0; i < 4; ++i)
#pragma unroll
                for (int e2 = 0; e2 < 2; ++e2) va[i][e2] = ld_nt(J.src + (size_t)(ka + 64 * i + 2 * lk2 + e2) * J.ldsrc + na + ln);
            if (two) {
#pragma unroll
                for (int i = 0; i < 4; ++i)
#pragma unroll
                    for (int e2 = 0; e2 < 2; ++e2) vb[i][e2] = ld_nt(J.src + (size_t)(kb + 64 * i + 2 * lk2 + e2) * J.ldsrc + nb + ln);
            }
            if (J.gain) {
#pragma unroll
                for (int i = 0; i < 4; ++i) { const float g0 = J.gain[ka + 64 * i + 2 * lk2], g1 = J.gain[ka + 64 * i + 2 * lk2 + 1]; va[i][0] *= g0; va[i][1] *= g1; }
                if (two) {
#pragma unroll
                    for (int i = 0; i < 4; ++i) { const float g0 = J.gain[kb + 64 * i + 2 * lk2], g1 = J.gain[kb + 64 * i + 2 * lk2 + 1]; vb[i][0] *= g0; vb[i][1] *= g1; }
                }
            }
            __syncthreads();
#pragma unroll
            for (int i = 0; i < 4; ++i)
#pragma unroll
                for (int q = 0; q < 4; ++q) s[(ln + q) * CVT_LDW + 32 * i + lk2] = cvt_pk_bf16(va[i][0][q], va[i][1][q]);
            if (two) {
#pragma unroll
                for (int i = 0; i < 4; ++i)
#pragma unroll
                    for (int q = 0; q < 4; ++q) s[64 * CVT_LDW + (ln + q) * CVT_LDW + 32 * i + lk2] = cvt_pk_bf16(vb[i][0][q], vb[i][1][q]);
            }
            __syncthreads();
#pragma unroll
            for (int i = 0; i < 4; ++i) {
                const int id = tid + 512 * i, rn = id >> 5, rk = (id & 31) << 3;
                const u32x2 w0 = *(const u32x2*)(s + rn * CVT_LDW + (rk >> 1)), w1 = *(const u32x2*)(s + rn * CVT_LDW + (rk >> 1) + 2);
                const int dn = map_col(J.mode, J.param, na + rn);
                u32x4 w; w.x = w0.x; w.y = w0.y; w.z = w1.x; w.w = w1.y;
                *(u32x4*)(J.dst + (size_t)dn * J.Kd + J.koff + ka + rk) = w;
            }
            if (two) {
#pragma unroll
                for (int i = 0; i < 4; ++i) {
                    const int id = tid + 512 * i, rn = id >> 5, rk = (id & 31) << 3;
                    const u32x2 w0 = *(const u32x2*)(s + (64 + rn) * CVT_LDW + (rk >> 1)), w1 = *(const u32x2*)(s + (64 + rn) * CVT_LDW + (rk >> 1) + 2);
                    const int dn = map_col(J.mode, J.param, nb + rn);
                    u32x4 w; w.x = w0.x; w.y = w0.y; w.z = w1.x; w.w = w1.y;
                    *(u32x4*)(J.dst + (size_t)dn * J.Kd + J.koff + kb + rk) = w;
                }
            }
        }
        base += nt;
    }
}
#define CVT_JOB(j) do { const CvtJob J_ = get_job(P, j); convert_job(J_, cvt_base, lds); } while (0)

__device__ __forceinline__ void phase0(const Params& P, char* lds) {
    const int tid = opq_tid(), wid = tid >> 6, lane = tid & 63;
    const int G = gridDim.x;
    {
        bf16_t* hb = (bf16_t*)(P.ws + OFF_HB); float* part = (float*)(P.ws + OFF_PART0);
        for (int row = blockIdx.x * 8 + wid; row < T; row += G * 8) {
            const float* xr = P.x + (size_t)row * DM; float ss = 0.f;
#pragma unroll
            for (int j = 0; j < 4; ++j) {
                const int c = j * 512 + lane * 8;
                const f32x4 a = ld_nt(xr + c), b = ld_nt(xr + c + 4);
                ss += (a[0] * a[0] + a[1] * a[1]) + (a[2] * a[2] + a[3] * a[3]) + (b[0] * b[0] + b[1] * b[1]) + (b[2] * b[2] + b[3] * b[3]);
                u32x4 w; w.x = cvt_pk_bf16(a[0], a[1]); w.y = cvt_pk_bf16(a[2], a[3]); w.z = cvt_pk_bf16(b[0], b[1]); w.w = cvt_pk_bf16(b[2], b[3]);
                *(u32x4*)(hb + (size_t)row * LDHB + 256 + c) = w;
            }
#pragma unroll
            for (int o = 32; o >= 1; o >>= 1) ss += __shfl_xor(ss, o);
            if (lane < 32) part[(size_t)row * 32 + lane] = ss * (1.0f / 32.0f);
            const f32x4 pv = ld_nt(P.p + (size_t)row * 256 + lane * 4);
            u32x2 pw; pw.x = cvt_pk_bf16(pv[0], pv[1]); pw.y = cvt_pk_bf16(pv[2], pv[3]);
            *(u32x2*)(hb + (size_t)row * LDHB + lane * 4) = pw;
        }
    }
    {
        float* rc = (float*)(P.ws + OFF_ROPEC); float* rs = (float*)(P.ws + OFF_ROPES);
        for (int i = blockIdx.x * 512 + tid; i < 2048 * 32; i += G * 512) {
            const int pos = i >> 5, f = i & 31;
            const float invf = __builtin_amdgcn_exp2f(-13.287712379549449f * (float)f * (1.0f / 32.0f));
            const float ang = (float)pos * invf;
            const double rev = (double)ang * 0.15915494309189535; const float fr = (float)(rev - __builtin_rint(rev));
            rc[i] = __builtin_amdgcn_cosf(fr); rs[i] = __builtin_amdgcn_sinf(fr);
        }
    }
    {
        u32x4* z = (u32x4*)(P.ws + OFF_WIN + 8256ull * LDB2K * 2); const u32x4 zero = {0u, 0u, 0u, 0u};
        for (int i = blockIdx.x * 512 + tid; i < 192 * LDB2K * 2 / 16; i += G * 512) z[i] = zero;
    }
    { int cvt_base = 0; CVT_JOB(0); CVT_JOB(1); CVT_JOB(2); CVT_JOB(3); CVT_JOB(4); CVT_JOB(5); CVT_JOB(6); CVT_JOB(7); CVT_JOB(8); CVT_JOB(9); CVT_JOB(10); __syncthreads(); }
}

constexpr int BM = 256, BK = 64, HALF = 128, HTB = HALF * BK * 2, STAGE_BYTES = 8 * HTB, NXCD = 8, WGM = 8;
__device__ __forceinline__ int lds_byte(int r, int c) { const int st = (r >> 4) * 2 + (c >> 5), rr = r & 15, cc = c & 31, ob = rr * 64 + cc * 2; return st * 1024 + (ob ^ (((ob >> 9) & 1) << 5)); }
__device__ __forceinline__ void stage_rc(int b, int& R, int& C) { const int st = b / 1024, sb = b % 1024, swz = sb ^ (((sb >> 9) & 1) << 5); R = (st >> 1) * 16 + swz / 64; C = (st & 1) * 32 + (swz % 64) / 2; }
__device__ __forceinline__ int perm32(int rho) { const int n = rho >> 4, i = rho & 15; return 8 * (i >> 2) + 4 * n + (i & 3); }

struct Unit { int pm, pn, z; };
struct GSched {
    const char* A0; const char* A1; const char* B0; const char* B1;
    int nM, nN0, nN1, n0, ntot, G, c, cut;
    __device__ __forceinline__ void init(const void* a0, const void* b0, int nM_, int nN0_, const void* a1, const void* b1, int nN1_) {
        A0 = (const char*)a0; B0 = (const char*)b0; A1 = (const char*)a1; B1 = (const char*)b1; nM = nM_; nN0 = nN0_; nN1 = nN1_; n0 = nM * nN0; ntot = n0 + nM * nN1; G = gridDim.x; c = blockIdx.x; cut = 0;
    }
    __device__ __forceinline__ bool next(int i, Unit& u) const {
        long L = (long)i * G + c;
        if (cut > 0 && i >= 2) { if (c >= cut) return false; L = 2l * G + (long)(i - 2) * cut + c; }
        if (L >= ntot) return false;
        const int z = L >= n0 ? 1 : 0; int wgid = (int)L - (z ? n0 : 0); const int nN = z ? nN1 : nN0, nwg = nM * nN;
        { const int q = nwg / NXCD, r = nwg % NXCD, xcd = wgid % NXCD, off = wgid / NXCD; wgid = (xcd < r ? xcd * (q + 1) : r * (q + 1) + (xcd - r) * q) + off; }
        const int nig = WGM * nN, gid = wgid / nig, fm = gid * WGM, gsz = (nM - fm) < WGM ? (nM - fm) : WGM;
        u.pm = fm + ((wgid % nig) % gsz); u.pn = (wgid % nig) / gsz; u.z = z; return true;
    }
};

typedef f32x4 Acc[2][2][4][2];

__device__ __forceinline__ float row_rstd32(const float* part, int row, int fq) {
    const float* q = part + (size_t)row * 32 + fq * 8;
    const f32x4 a = *(const f32x4*)q, b = *(const f32x4*)(q + 4);
    float s = ((a[0] + a[1]) + (a[2] + a[3])) + ((b[0] + b[1]) + (b[2] + b[3]));
    s += __shfl_xor(s, 16); s += __shfl_xor(s, 32);
    return __builtin_amdgcn_rsqf(s * (1.0f / 2048.0f) + EPS);
}
__device__ __forceinline__ float sumsq4(const f32x4 v) { return (v[0] * v[0] + v[1] * v[1]) + (v[2] * v[2] + v[3] * v[3]); }
__device__ __forceinline__ u32x4 pack8(const f32x4 a, const f32x4 b) { u32x4 w; w.x = cvt_pk_bf16(a[0], a[1]); w.y = cvt_pk_bf16(a[2], a[3]); w.z = cvt_pk_bf16(b[0], b[1]); w.w = cvt_pk_bf16(b[2], b[3]); return w; }
__device__ __forceinline__ void unpack8(const u32x4 w, f32x4& a, f32x4& b) { a = (f32x4){bf_lo(w.x), bf_hi(w.x), bf_lo(w.y), bf_hi(w.y)}; b = (f32x4){bf_lo(w.z), bf_hi(w.z), bf_lo(w.w), bf_hi(w.w)}; }


__device__ __forceinline__ void rstd_regs32(float (&rsv)[8], const float* part, int row0, int fq) {
    int r0 = row0; asm volatile("" : "+v"(r0));
    const float* q = part + (size_t)r0 * 32 + fq * 8;
    f32x4 a[8], b[8];
#pragma unroll
    for (int g = 0; g < 8; ++g) { const float* p = q + (size_t)((g >> 2) * HALF + (g & 3) * 16) * 32; a[g] = *(const f32x4*)p; b[g] = *(const f32x4*)(p + 4); }
#pragma unroll
    for (int g = 0; g < 8; ++g) { float s = ((a[g][0] + a[g][1]) + (a[g][2] + a[g][3])) + ((b[g][0] + b[g][1]) + (b[g][2] + b[g][3]));
        s += __shfl_xor(s, 16); s += __shfl_xor(s, 32); rsv[g] = __builtin_amdgcn_rsqf(s * (1.0f / 2048.0f) + EPS); }
}
__device__ __forceinline__ void rstd_regs_lat(float (&rsv)[8], const float* latpart, int row0, int z) {
    int r0 = row0; asm volatile("" : "+v"(r0));
    const float* q = latpart + (size_t)r0 * 16 + z * 8;
    f32x4 a[8], b[8];
#pragma unroll
    for (int g = 0; g < 8; ++g) { const float* p = q + (size_t)((g >> 2) * HALF + (g & 3) * 16) * 16; a[g] = *(const f32x4*)p; b[g] = *(const f32x4*)(p + 4); }
#pragma unroll
    for (int g = 0; g < 8; ++g) { const float s = ((a[g][0] + a[g][1]) + (a[g][2] + a[g][3])) + ((b[g][0] + b[g][1]) + (b[g][2] + b[g][3]));
        rsv[g] = __builtin_amdgcn_rsqf(s * (1.0f / 512.0f) + EPS); }
}
struct EpiSwiglu {
    static constexpr bool NARROW = false; static constexpr bool HAS_MID = false; int mid_t;
    static constexpr bool RSTD = true;
    __device__ __forceinline__ void rstd_fill(float (&rsv)[8], const Unit& u, int wr, int fr, int fq) const { rstd_regs32(rsv, part, u.pm * BM + wr * 64 + fr, fq); }
    bf16_t* act; const float* part;
    __device__ __forceinline__ void mid(Acc&, const Unit&, int, int, int, int) const {}
    __device__ __forceinline__ void operator()(Acc& acc, const Unit& u, int wr, int wc, int fr, int fq, const float (&rsv)[8]) const {
        const int row0 = u.pm * BM + wr * 64 + fr, col = u.pn * 128 + wc * 32 + 8 * fq;
#pragma unroll
        for (int ai = 0; ai < 2; ++ai)
#pragma unroll
            for (int m = 0; m < 4; ++m) {
                const int row = row0 + ai * HALF + m * 16; const float rs = rsv[ai * 4 + m];
                f32x4 o[2];
                const float rsn = rs * -1.4426950408889634f, rs2 = rs * rs;
#pragma unroll
                for (int n = 0; n < 2; ++n) { const f32x4 g = acc[ai][0][m][n], uu = acc[ai][1][m][n]; const f32x4 t = g * rsn, w = (g * uu) * rs2;
#pragma unroll
                    for (int j = 0; j < 4; ++j) o[n][j] = w[j] * __builtin_amdgcn_rcpf(1.0f + __builtin_amdgcn_exp2f(t[j])); }
                st_nt(act + (size_t)row * LDACT + col, pack8(o[0], o[1]));
            }
    }
};
template <bool F32IN> struct EpiResid {
    static constexpr bool NARROW = false; static constexpr bool HAS_MID = false; int mid_t;
    static constexpr bool RSTD = false;
    __device__ __forceinline__ void rstd_fill(float (&rsv)[8], const Unit& u, int wr, int fr, int fq) const { }
    const float* hin; bf16_t* hb; float* part; float scale;
    __device__ __forceinline__ void mid(Acc&, const Unit&, int, int, int, int) const {}
    __device__ __forceinline__ void operator()(Acc& acc, const Unit& u, int wr, int wc, int fr, int fq, const float (&rsv)[8]) const {
        const int row0 = u.pm * BM + wr * 64 + fr, col0 = u.pn * BM + wc * 32 + 8 * fq;
        if constexpr (F32IN) {
            f32x4 w[4][4];
#pragma unroll
            for (int g = 0; g < 4; ++g) { const float* hp = hin + (size_t)(row0 + (g >> 2) * HALF + (g & 3) * 16) * DM + col0;
                w[g][0] = ld_nt(hp); w[g][1] = ld_nt(hp + 4); w[g][2] = ld_nt(hp + HALF); w[g][3] = ld_nt(hp + HALF + 4); }
#pragma unroll
            for (int g = 0; g < 8; ++g) {
                const int ai = g >> 2, m = g & 3, s = g & 3;
                const int row = row0 + ai * HALF + m * 16;
                float ss = 0.f;
#pragma unroll
                for (int bj = 0; bj < 2; ++bj) {
                    const f32x4 v0 = w[s][bj * 2] + acc[ai][bj][m][0] * scale, v1 = w[s][bj * 2 + 1] + acc[ai][bj][m][1] * scale;
                    ss += sumsq4(v0) + sumsq4(v1);
                    *(u32x4*)(hb + (size_t)row * LDHB + 256 + col0 + bj * HALF) = pack8(v0, v1); }
                ss += __shfl_xor(ss, 16); ss += __shfl_xor(ss, 32);
                if (fq == 0) part[(size_t)row * 32 + u.pn * 4 + wc] = ss;
                asm volatile("" ::: "memory");
                if (g + 4 < 8) { const int g4 = g + 4; const float* hp = hin + (size_t)(row0 + (g4 >> 2) * HALF + (g4 & 3) * 16) * DM + col0;
                    w[s][0] = ld_nt(hp); w[s][1] = ld_nt(hp + 4); w[s][2] = ld_nt(hp + HALF); w[s][3] = ld_nt(hp + HALF + 4); }
            }
        } else {
            u32x4 w[8][2];
#pragma unroll
            for (int g = 0; g < 8; ++g)
#pragma unroll
                for (int bj = 0; bj < 2; ++bj) w[g][bj] = *(const u32x4*)(hb + (size_t)(row0 + (g >> 2) * HALF + (g & 3) * 16) * LDHB + 256 + col0 + bj * HALF);
#pragma unroll
            for (int g = 0; g < 8; ++g) {
                const int ai = g >> 2, m = g & 3;
                const int row = row0 + ai * HALF + m * 16;
                float ss = 0.f;
#pragma unroll
                for (int bj = 0; bj < 2; ++bj) { f32x4 h0, h1; unpack8(w[g][bj], h0, h1);
                    const f32x4 v0 = h0 + acc[ai][bj][m][0] * scale, v1 = h1 + acc[ai][bj][m][1] * scale;
                    ss += sumsq4(v0) + sumsq4(v1);
                    *(u32x4*)(hb + (size_t)row * LDHB + 256 + col0 + bj * HALF) = pack8(v0, v1); }
                ss += __shfl_xor(ss, 16); ss += __shfl_xor(ss, 32);
                if (fq == 0) part[(size_t)row * 32 + u.pn * 4 + wc] = ss;
            }
        }
    }
};

struct EpiWin {
    static constexpr bool NARROW = false; static constexpr bool HAS_MID = false; int mid_t;
    static constexpr bool RSTD = true;
    __device__ __forceinline__ void rstd_fill(float (&rsv)[8], const Unit& u, int wr, int fr, int fq) const { rstd_regs32(rsv, part, u.pm * BM + wr * 64 + fr, fq); }
    bf16_t* qkv; bf16_t* lat; float* latpart; const float* part;
    __device__ __forceinline__ void mid(Acc&, const Unit&, int, int, int, int) const {}
    __device__ __forceinline__ void operator()(Acc& acc, const Unit& u, int wr, int wc, int fr, int fq, const float (&rsv)[8]) const {
        const int row0 = u.pm * BM + wr * 64 + fr, cin = wc * 32 + 8 * fq;
        const bool is_lat = u.pn >= 12;
#pragma unroll
        for (int ai = 0; ai < 2; ++ai)
#pragma unroll
            for (int m = 0; m < 4; ++m) {
                const int row = row0 + ai * HALF + m * 16; const float rs = rsv[ai * 4 + m]; float ss = 0.f;
#pragma unroll
                for (int bj = 0; bj < 2; ++bj) { const f32x4 v0 = acc[ai][bj][m][0] * rs, v1 = acc[ai][bj][m][1] * rs; ss += sumsq4(v0) + sumsq4(v1);
                    bf16_t* dst = is_lat ? lat + (size_t)row * 1024 + (u.pn - 12) * BM + cin + bj * HALF : qkv + (size_t)row * 3072 + u.pn * BM + cin + bj * HALF;
                    st_nt(dst, pack8(v0, v1)); }
                if (is_lat) { ss += __shfl_xor(ss, 16); ss += __shfl_xor(ss, 32); if (fq == 0) latpart[(size_t)row * 16 + (u.pn - 12) * 4 + wc] = ss; }
            }
    }
};
struct EpiGates {
    static constexpr bool NARROW = false; static constexpr bool HAS_MID = false; int mid_t;
    static constexpr bool RSTD = true;
    __device__ __forceinline__ void rstd_fill(float (&rsv)[8], const Unit& u, int wr, int fr, int fq) const { rstd_regs32(rsv, part, u.pm * BM + wr * 64 + fr, fq); }
    bf16_t* gates; const float* part;
    __device__ __forceinline__ void mid(Acc&, const Unit&, int, int, int, int) const {}
    __device__ __forceinline__ void operator()(Acc& acc, const Unit& u, int wr, int wc, int fr, int fq, const float (&rsv)[8]) const {
        const int row0 = u.pm * BM + wr * 64 + fr, col = u.pn * HALF + wc * 32 + 8 * fq;
#pragma unroll
        for (int ai = 0; ai < 2; ++ai)
#pragma unroll
            for (int m = 0; m < 4; ++m) {
                const int row = row0 + ai * HALF + m * 16; const float rs = rsv[ai * 4 + m];
                f32x4 r0, r1, b0, b1;
#pragma unroll
                for (int jj = 0; jj < 4; ++jj) {
                    const float rsn = rs * -1.4426950408889634f;
                    const float da0 = 1.0f + __builtin_amdgcn_exp2f(acc[ai][0][m][0][jj] * rsn), da1 = 1.0f + __builtin_amdgcn_exp2f(acc[ai][0][m][1][jj] * rsn);
                    const float db0 = 1.0f + __builtin_amdgcn_exp2f(acc[ai][1][m][0][jj] * rsn), db1 = 1.0f + __builtin_amdgcn_exp2f(acc[ai][1][m][1][jj] * rsn);
                    b0[jj] = __builtin_amdgcn_rcpf(db0); b1[jj] = __builtin_amdgcn_rcpf(db1);
                    r0[jj] = db0 * __builtin_amdgcn_rcpf(da0); r1[jj] = db1 * __builtin_amdgcn_rcpf(da1); }
                st_nt(gates + (size_t)row * 4096 + col, pack8(r0, r1));
                st_nt(gates + (size_t)row * 4096 + 2048 + col, pack8(b0, b1));
            }
    }
};
struct EpiKrope {
    static constexpr bool NARROW = true; static constexpr bool HAS_MID = false; int mid_t;
    static constexpr bool RSTD = true;
    __device__ __forceinline__ void rstd_fill(float (&rsv)[8], const Unit& u, int wr, int fr, int fq) const { rstd_regs32(rsv, part, u.pm * BM + wr * 64 + fr, fq); }
    bf16_t* krope; const float* part; const float* rc; const float* rsn;
    __device__ __forceinline__ void mid(Acc&, const Unit&, int, int, int, int) const {}
    __device__ __forceinline__ void operator()(Acc& acc, const Unit& u, int wr, int wc, int fr, int fq, const float (&rsv)[8]) const {
        if (wc >= 2) return;
        const int row0 = u.pm * BM + wr * 64 + fr, k = wc * 4 + fq;
#pragma unroll
        for (int ai = 0; ai < 2; ++ai)
#pragma unroll
            for (int m = 0; m < 4; ++m) {
                const int row = row0 + ai * HALF + m * 16; const float rs = rsv[ai * 4 + m]; const int pos = row & (SEQ - 1);
                const f32x4 c = *(const f32x4*)(rc + pos * 32 + 4 * k), s = *(const f32x4*)(rsn + pos * 32 + 4 * k);
                const f32x4 x1 = acc[ai][0][m][0] * rs, x2 = acc[ai][0][m][1] * rs;
                const f32x4 o1 = x1 * c - x2 * s, o2 = x2 * c + x1 * s;
                *(u32x4*)(krope + (size_t)row * 64 + wc * 32 + 8 * fq) = pack8(o1, o2);
            }
    }
};
struct EpiUp {
    static constexpr bool NARROW = false; static constexpr bool HAS_MID = false; int mid_t;
    static constexpr bool RSTD = true;
    __device__ __forceinline__ void rstd_fill(float (&rsv)[8], const Unit& u, int wr, int fr, int fq) const { rstd_regs_lat(rsv, latpart, u.pm * BM + wr * 64 + fr, u.z); }
    bf16_t* q; bf16_t* kv; const float* latpart; const float* rc; const float* rsn;
    __device__ __forceinline__ void mid(Acc&, const Unit&, int, int, int, int) const {}
    __device__ __forceinline__ void operator()(Acc& acc, const Unit& u, int wr, int wc, int fr, int fq, const float (&rsv)[8]) const {
        const int row0 = u.pm * BM + wr * 64 + fr, col0 = u.pn * BM + wc * 32 + 8 * fq;
        const int off0 = col0 % 192, off1 = (col0 + HALF) % 192;
        const int ropebj = (u.z == 0) ? (off0 >= 128 ? 0 : (off1 >= 128 ? 1 : -1)) : -1;
        const int kk = ((ropebj == 0 ? off0 : off1) - 128) >> 3;
        f32x4 cs[8], sn[8];
        if (ropebj >= 0) {
#pragma unroll
            for (int g = 0; g < 8; ++g) { const int pos = (row0 + (g >> 2) * HALF + (g & 3) * 16) & (SEQ - 1); cs[g] = *(const f32x4*)(rc + pos * 32 + 4 * kk); sn[g] = *(const f32x4*)(rsn + pos * 32 + 4 * kk); }
        } else {
#pragma unroll
            for (int g = 0; g < 8; ++g) { cs[g] = (f32x4){1.f, 1.f, 1.f, 1.f}; sn[g] = (f32x4){0.f, 0.f, 0.f, 0.f}; }
        }
#pragma unroll
        for (int ai = 0; ai < 2; ++ai)
#pragma unroll
            for (int m = 0; m < 4; ++m) {
                const int row = row0 + ai * HALF + m * 16;
                const float rs = rsv[ai * 4 + m];
#pragma unroll
                for (int bj = 0; bj < 2; ++bj) { const int col = col0 + bj * HALF; f32x4 v0 = acc[ai][bj][m][0] * rs, v1 = acc[ai][bj][m][1] * rs;
                    if (bj == ropebj) { const f32x4 c = cs[ai * 4 + m], s = sn[ai * 4 + m]; const f32x4 o1 = v0 * c - v1 * s, o2 = v1 * c + v0 * s; v0 = o1; v1 = o2; }
                    if (u.z == 0) st_nt(q + (size_t)row * 1536 + col, pack8(v0, v1));
                    else st_nt(kv + (size_t)row * 2048 + col, pack8(v0, v1)); }
            }
    }
};
struct EpiMerge {
    static constexpr bool NARROW = false; static constexpr bool HAS_MID = true; int mid_t;
    static constexpr bool RSTD = false;
    __device__ __forceinline__ void rstd_fill(float (&rsv)[8], const Unit& u, int wr, int fr, int fq) const { }
    bf16_t* merged; const bf16_t* gates;
    __device__ __forceinline__ void mid(Acc& acc, const Unit& u, int wr, int wc, int fr, int fq) const {
        int row0 = u.pm * BM + wr * 64 + fr; asm volatile("" : "+v"(row0));
        const bf16_t* gb = gates + (size_t)row0 * 4096 + u.pn * BM + wc * 32 + 8 * fq;
#pragma unroll
        for (int ai = 0; ai < 2; ++ai)
#pragma unroll
            for (int mp = 0; mp < 1; ++mp) {
                u32x4 ga[4][2];
#pragma unroll
                for (int mm = 0; mm < 4; ++mm)
#pragma unroll
                    for (int bj = 0; bj < 2; ++bj) { const bf16_t* g = gb + (size_t)(ai * HALF + mm * 16) * 4096 + bj * HALF; ga[mm][bj] = ld_nt(g); }
#pragma unroll
                for (int mm = 0; mm < 4; ++mm)
#pragma unroll
                    for (int bj = 0; bj < 2; ++bj) { const int m = mm; f32x4 a0, a1; unpack8(ga[mm][bj], a0, a1);
#pragma unroll
                        for (int j = 0; j < 4; ++j) { acc[ai][bj][m][0][j] *= a0[j]; acc[ai][bj][m][1][j] *= a1[j]; } }
                asm volatile("" ::: "memory"); }
    }
    __device__ __forceinline__ void operator()(Acc& acc, const Unit& u, int wr, int wc, int fr, int fq, const float (&rsv)[8]) const {
        const int row0 = u.pm * BM + wr * 64 + fr, col0 = u.pn * BM + wc * 32 + 8 * fq;
        u32x4 gs[8][2];
#pragma unroll
        for (int g = 0; g < 8; ++g)
#pragma unroll
            for (int bj = 0; bj < 2; ++bj) gs[g][bj] = ld_nt(gates + (size_t)(row0 + (g >> 2) * HALF + (g & 3) * 16) * 4096 + 2048 + col0 + bj * HALF);
#pragma unroll
        for (int g = 0; g < 8; ++g) { const int ai = g >> 2, m = g & 3; const int row = row0 + ai * HALF + m * 16;
#pragma unroll
            for (int bj = 0; bj < 2; ++bj) { f32x4 b0, b1; unpack8(gs[g][bj], b0, b1);
                st_nt(merged + (size_t)row * 2048 + col0 + bj * HALF, pack8(acc[ai][bj][m][0] * b0, acc[ai][bj][m][1] * b1)); } }
    }
};
struct EpiPl {
    static constexpr bool NARROW = false; static constexpr bool HAS_MID = true; int mid_t;
    static constexpr bool RSTD = true;
    __device__ __forceinline__ void rstd_fill(float (&rsv)[8], const Unit& u, int wr, int fr, int fq) const { rstd_regs32(rsv, part_in, u.pm * BM + wr * 64 + fr, fq); }
    bf16_t* h4b; const bf16_t* hb; bf16_t* etmp; const float* part_in; float* part_out;
    __device__ __forceinline__ void mid(Acc& acc, const Unit& u, int wr, int wc, int fr, int fq) const {
        int row0 = u.pm * BM + wr * 64 + fr; asm volatile("" : "+v"(row0));
        bf16_t* eb = etmp + (size_t)row0 * 2048 + u.pn * BM + wc * 32 + 8 * fq;
#pragma unroll
        for (int ai = 0; ai < 2; ++ai)
#pragma unroll
            for (int m = 0; m < 4; ++m) {
#pragma unroll
                for (int bj = 0; bj < 2; ++bj) { *(u32x4*)(eb + (size_t)(ai * HALF + m * 16) * 2048 + bj * HALF) = pack8(acc[ai][bj][m][0], acc[ai][bj][m][1]);
                    acc[ai][bj][m][0] = (f32x4){0.f, 0.f, 0.f, 0.f}; acc[ai][bj][m][1] = (f32x4){0.f, 0.f, 0.f, 0.f}; } }
    }
    __device__ __forceinline__ void operator()(Acc& acc, const Unit& u, int wr, int wc, int fr, int fq, const float (&rsv)[8]) const {
        const int row0 = u.pm * BM + wr * 64 + fr, col0 = u.pn * BM + wc * 32 + 8 * fq;
        u32x4 hw[4][2], ew[4][2];
#pragma unroll
        for (int g = 0; g < 4; ++g) { const int r = row0 + (g >> 2) * HALF + (g & 3) * 16;
#pragma unroll
            for (int bj = 0; bj < 2; ++bj) { hw[g][bj] = *(const u32x4*)(hb + (size_t)r * LDHB + 256 + col0 + bj * HALF); ew[g][bj] = ld_nt(etmp + (size_t)r * DM + col0 + bj * HALF); } }
#pragma unroll
        for (int g = 0; g < 8; ++g) {
            const int ai = g >> 2, m = g & 3, s = g & 3; const int row = row0 + ai * HALF + m * 16;
            const float rs = rsv[ai * 4 + m]; float ss = 0.f;
#pragma unroll
            for (int bj = 0; bj < 2; ++bj) { const size_t off = (size_t)row * DM + col0 + bj * HALF;
                f32x4 e0, e1, v0, v1; unpack8(ew[s][bj], e0, e1); unpack8(hw[s][bj], v0, v1);
#pragma unroll
                for (int jj = 0; jj < 4; ++jj) { v0[jj] += sigmoidf_(acc[ai][bj][m][0][jj] * rs) * e0[jj]; v1[jj] += sigmoidf_(acc[ai][bj][m][1][jj] * rs) * e1[jj]; }
                st_nt(h4b + off, pack8(v0, v1)); ss += sumsq4(v0) + sumsq4(v1); }
            ss += __shfl_xor(ss, 16); ss += __shfl_xor(ss, 32);
            if (fq == 0) part_out[(size_t)row * 32 + u.pn * 4 + wc] = ss;
            asm volatile("" ::: "memory");
            if (g + 4 < 8) { const int r = row0 + ((g + 4) >> 2) * HALF + ((g + 4) & 3) * 16;
#pragma unroll
                for (int bj = 0; bj < 2; ++bj) { hw[s][bj] = *(const u32x4*)(hb + (size_t)r * LDHB + 256 + col0 + bj * HALF); ew[s][bj] = ld_nt(etmp + (size_t)r * DM + col0 + bj * HALF); } }
        }
    }
};

template <class Epi>
__device__ __forceinline__ void gemm_phase(LAS unsigned char* lds, const GSched& S, const int K, const int lda, const int ldb, const Epi& E) {
    const int tid = opq_tid(), wid = __builtin_amdgcn_readfirstlane(tid >> 6), lane = tid & 63, wr = wid >> 2, wc = wid & 3, fr = lane & 15, fq = lane >> 4;
    const int nt = K / BK;
    unsigned voffA[2], voffB[2];
#pragma unroll
    for (int i = 0; i < 2; ++i) { int R, C; stage_rc(tid * 16 + i * 8192, R, C); const int Rb = (R & ~31) + perm32(R & 31);
        voffA[i] = (unsigned)(R * lda + C) * 2u; voffB[i] = (unsigned)(Rb * ldb + C) * 2u; }
    const size_t kstep = (size_t)(BK * 2);
    const size_t hstepA = (size_t)HALF * lda * 2, hstepB = (size_t)HALF * ldb * 2;
    const size_t tstepA = 2 * hstepA, tstepB = 2 * hstepB;
    const unsigned ldsw = (unsigned)wid * 1024u;
    const int aoff = lds_byte(wr * 64 + fr, fq * 8), boff = lds_byte(wc * 32 + fr, fq * 8);
#define PG8_SA(b, h) (((b) * 2 + (h)) * HTB)
#define PG8_SB(b, h) ((4 + (b) * 2 + (h)) * HTB)
#define PG8_STAGE(bufoff, gbase, voff) do { _Pragma("unroll") for (int _i = 0; _i < 2; ++_i) \
        __builtin_amdgcn_global_load_lds((const unsigned*)((const char*)(gbase) + (voff)[_i]), (LAS unsigned*)(lds + (bufoff) + ldsw + _i * 8192), 16, 0, 0); } while (0)
#define PG8_LDA(dst, b, h) do { _Pragma("unroll") for (int m = 0; m < 4; ++m) _Pragma("unroll") for (int k = 0; k < 2; ++k) dst[m][k] = *(const LAS bf16x8*)(lds + PG8_SA(b, h) + aoff + m * 2048 + k * 1024); } while (0)
#define PG8_LDB(dst, b, h) do { _Pragma("unroll") for (int n = 0; n < 2; ++n) _Pragma("unroll") for (int k = 0; k < 2; ++k) dst[n][k] = *(const LAS bf16x8*)(lds + PG8_SB(b, h) + boff + n * 2048 + k * 1024); } while (0)
#define PG8_MMA(ai, bj, At, Bt) do { __builtin_amdgcn_s_setprio(1); _Pragma("unroll") for (int m = 0; m < 4; ++m) _Pragma("unroll") for (int n = 0; n < 2; ++n) _Pragma("unroll") for (int k = 0; k < 2; ++k) \
        acc[ai][bj][m][n] = __builtin_amdgcn_mfma_f32_16x16x32_bf16(Bt[n][k], At[m][k], acc[ai][bj][m][n], 0, 0, 0); __builtin_amdgcn_s_setprio(0); } while (0)
#define PG8_WAIT_V(n) asm volatile("s_waitcnt vmcnt(" #n ")" ::: "memory")
#define PG8_WAIT_L(n) asm volatile("s_waitcnt lgkmcnt(" #n ")" ::: "memory")
#define PG8_BAR __builtin_amdgcn_s_barrier()
#define PG8_SCHED __builtin_amdgcn_sched_barrier(0)
    Unit cur, nxt; int ui = 0;
    if (!S.next(0, cur)) return;
    Acc acc;
#pragma unroll
    for (int a = 0; a < 2; ++a)
#pragma unroll
        for (int b = 0; b < 2; ++b)
#pragma unroll
            for (int m = 0; m < 4; ++m)
#pragma unroll
                for (int n = 0; n < 2; ++n) acc[a][b][m][n] = (f32x4){0.f, 0.f, 0.f, 0.f};
    bf16x8 At[4][2], B0[2][2], B1[2][2];
    const char* cA = (cur.z ? S.A1 : S.A0) + (size_t)cur.pm * tstepA; const char* cB = (cur.z ? S.B1 : S.B0) + (size_t)cur.pn * tstepB;
    float rsv[8];
#pragma unroll
    for (int g = 0; g < 8; ++g) rsv[g] = 0.f;
    PG8_STAGE(PG8_SB(0, 0), cB, voffB); PG8_STAGE(PG8_SA(0, 0), cA, voffA); PG8_STAGE(PG8_SB(0, 1), cB + hstepB, voffB); PG8_STAGE(PG8_SA(0, 1), cA + hstepA, voffA);
    if constexpr (Epi::RSTD) { PG8_SCHED; E.rstd_fill(rsv, cur, wr, fr, fq); PG8_SCHED; }
    if (wr == 1) PG8_BAR;
    PG8_WAIT_V(4); PG8_BAR;
    PG8_STAGE(PG8_SB(1, 0), cB + kstep, voffB); PG8_STAGE(PG8_SA(1, 0), cA + kstep, voffA); PG8_STAGE(PG8_SB(1, 1), cB + hstepB + kstep, voffB);
    PG8_WAIT_V(6); PG8_BAR;
    for (;;) {
        const bool has_next = S.next(ui + 1, nxt);
        const char* nA = has_next ? (nxt.z ? S.A1 : S.A0) + (size_t)nxt.pm * tstepA : cA; const char* nB = has_next ? (nxt.z ? S.B1 : S.B0) + (size_t)nxt.pn * tstepB : cB;
        for (int t = 0; t < nt; t += 2) {
            const bool last = (t == nt - 2);
            const char* a1 = cA + (size_t)(t + 1) * kstep;
            const char* a2 = last ? nA : cA + (size_t)(t + 2) * kstep; const char* b2 = last ? nB : cB + (size_t)(t + 2) * kstep;
            const char* a3 = a2 + kstep; const char* b3 = b2 + kstep;
            PG8_LDB(B0, 0, 0); PG8_SCHED; PG8_LDA(At, 0, 0); PG8_STAGE(PG8_SA(1, 1), a1 + hstepA, voffA);
            PG8_WAIT_L(8); PG8_BAR; PG8_WAIT_L(0); PG8_MMA(0, 0, At, B0); PG8_BAR; PG8_SCHED;
            if constexpr (!Epi::NARROW) PG8_LDB(B1, 0, 1); PG8_STAGE(PG8_SB(0, 0), b2, voffB);
            PG8_BAR; PG8_WAIT_L(0); if constexpr (!Epi::NARROW) PG8_MMA(0, 1, At, B1); PG8_BAR;
            PG8_LDA(At, 0, 1); PG8_STAGE(PG8_SA(0, 0), a2, voffA);
            PG8_BAR; PG8_WAIT_L(0); PG8_MMA(1, 0, At, B0); PG8_BAR; PG8_SCHED;
            PG8_STAGE(PG8_SB(0, 1), b2 + hstepB, voffB);
            PG8_WAIT_V(6); PG8_BAR; if constexpr (!Epi::NARROW) PG8_MMA(1, 1, At, B1); PG8_BAR;
            PG8_LDB(B0, 1, 0); PG8_SCHED; PG8_LDA(At, 1, 0); PG8_STAGE(PG8_SA(0, 1), a2 + hstepA, voffA);
            PG8_WAIT_L(8); PG8_BAR; PG8_WAIT_L(0); PG8_MMA(0, 0, At, B0); PG8_BAR; PG8_SCHED;
            if constexpr (!Epi::NARROW) PG8_LDB(B1, 1, 1); PG8_STAGE(PG8_SB(1, 0), b3, voffB);
            PG8_BAR; PG8_WAIT_L(0); if constexpr (!Epi::NARROW) PG8_MMA(0, 1, At, B1); PG8_BAR;
            PG8_LDA(At, 1, 1); PG8_STAGE(PG8_SA(1, 0), a3, voffA);
            PG8_BAR; PG8_WAIT_L(0); PG8_MMA(1, 0, At, B0); PG8_BAR; PG8_SCHED;
            PG8_STAGE(PG8_SB(1, 1), b3 + hstepB, voffB);
            PG8_WAIT_V(6); PG8_BAR; if constexpr (!Epi::NARROW) PG8_MMA(1, 1, At, B1); PG8_BAR;
            if constexpr (Epi::HAS_MID) { if (t + 2 == E.mid_t) { PG8_SCHED; E.mid(acc, cur, wr, wc, fr, fq); PG8_SCHED; } }
        }
        E(acc, cur, wr, wc, fr, fq, rsv);
        if (!has_next) break;
        if constexpr (Epi::RSTD) { if (nxt.pm != cur.pm || nxt.z != cur.z) { PG8_SCHED; E.rstd_fill(rsv, nxt, wr, fr, fq); PG8_SCHED; } }
#pragma unroll
        for (int a = 0; a < 2; ++a)
#pragma unroll
            for (int b = 0; b < 2; ++b)
#pragma unroll
                for (int m = 0; m < 4; ++m)
#pragma unroll
                    for (int n = 0; n < 2; ++n) acc[a][b][m][n] = (f32x4){0.f, 0.f, 0.f, 0.f};
        cur = nxt; cA = nA; cB = nB; ++ui;
    }
    PG8_WAIT_V(0);
    if (wr == 0) PG8_BAR;
    PG8_BAR;
#undef PG8_SA
#undef PG8_SB
#undef PG8_STAGE
#undef PG8_LDA
#undef PG8_LDB
#undef PG8_MMA
#undef PG8_WAIT_V
#undef PG8_WAIT_L
#undef PG8_BAR
#undef PG8_SCHED
}

constexpr int KVBLK = 64;
constexpr size_t SHM_V = KVBLK * 128 * 2, SHM_K = KVBLK * 128 * 2, SHM_K2 = KVBLK * 64 * 2;
constexpr size_t AOFF_V = 0, AOFF_K = 2 * SHM_V, AOFF_K2 = AOFF_K + 2 * SHM_K, AOFF_WS = AOFF_K2 + 2 * SHM_K2, AOFF_TBL = AOFF_WS + 8 * 64 * 4, AOFF_Q2 = AOFF_TBL + 15 * 128 * 4, ATT_LDS_END = AOFF_Q2 + 8 * 4096;
#define KSWZ(row, colB) ((row) * 256 + ((colB) ^ (((row) & 7) << 4)))
#define K2SWZ(row, colB) ((row) * 128 + ((colB) ^ (((row) & 7) << 4)))
#define SBAR() __builtin_amdgcn_sched_barrier(0)
__device__ __forceinline__ int crow(int r, int hi) { return (r & 3) + 8 * (r >> 2) + 4 * hi; }

template <int MODE> struct ACfg;
template <> struct ACfg<0> { static constexpr int ND0 = 12, LDQ = 1536, LDK = 2048, LDV = 2048, SDEPTH = 1, NLD = 5; static constexpr float SCALE = 0.07216878364870322f; };
template <> struct ACfg<1> { static constexpr int ND0 = 8, LDQ = 3072, LDK = 3072, LDV = 3072, SDEPTH = 1, NLD = 4; static constexpr float SCALE = 0.08838834764831845f; };
constexpr float ATT_THR = 8.f;

template <int MODE>
__device__ __forceinline__ void partialSM(f32x16& p0, f32x16& p1, float& m_reg, float& mn, float& alpha) {
    constexpr float SC = ACfg<MODE>::SCALE, C = SC * 1.4426950408889634f;
    float pmax = p0[0];
#pragma unroll
    for (int r = 1; r < 16; ++r) pmax = fmaxf(pmax, p0[r]);
#pragma unroll
    for (int r = 0; r < 16; ++r) pmax = fmaxf(pmax, p1[r]);
    { auto rr = __builtin_amdgcn_permlane32_swap(__float_as_uint(pmax), __float_as_uint(pmax), false, false);
      pmax = fmaxf(__uint_as_float(rr[0]), __uint_as_float(rr[1])); }
    if (__builtin_expect(__all(pmax - m_reg <= ATT_THR / SC), 1)) { mn = m_reg; alpha = 1.f; }
    else { mn = fmaxf(m_reg, pmax); alpha = __builtin_amdgcn_exp2f((m_reg - mn) * C); m_reg = mn; }
    const float mnC = -mn * C;
#pragma unroll
    for (int r = 0; r < 16; ++r) p0[r] = fmaf(p0[r], C, mnC);
#pragma unroll
    for (int r = 0; r < 16; ++r) p1[r] = fmaf(p1[r], C, mnC);
#pragma unroll
    for (int r = 0; r < 16; ++r) p0[r] = __builtin_amdgcn_exp2f(p0[r]);
}
__device__ __forceinline__ void finishSM(f32x16& p0, f32x16& p1, float alpha, float& l_reg, bf16x8& pa0, bf16x8& pa1, bf16x8& pa2, bf16x8& pa3) {
#pragma unroll
    for (int r = 0; r < 16; ++r) p1[r] = __builtin_amdgcn_exp2f(p1[r]);
    float ps = 0;
#pragma unroll
    for (int r = 0; r < 16; ++r) ps += p0[r];
#pragma unroll
    for (int r = 0; r < 16; ++r) ps += p1[r];
    { auto rr = __builtin_amdgcn_permlane32_swap(__float_as_uint(ps), __float_as_uint(ps), false, false);
      ps = __uint_as_float(rr[0]) + __uint_as_float(rr[1]); }
    l_reg = l_reg * alpha + ps;
#define PK4(P, BASE, OUT) do { unsigned a0 = cvt_pk_bf16(P[BASE + 0], P[BASE + 1]), a1 = cvt_pk_bf16(P[BASE + 2], P[BASE + 3]);   \
    unsigned b0 = cvt_pk_bf16(P[BASE + 4], P[BASE + 5]), b1 = cvt_pk_bf16(P[BASE + 6], P[BASE + 7]);                              \
    auto r0 = __builtin_amdgcn_permlane32_swap(a0, b0, false, false); auto r1 = __builtin_amdgcn_permlane32_swap(a1, b1, false, false); \
    u32x4 w = {r0[0], r1[0], r0[1], r1[1]}; OUT = *reinterpret_cast<bf16x8*>(&w); } while (0)
    PK4(p0, 0, pa0); PK4(p0, 8, pa1); PK4(p1, 0, pa2); PK4(p1, 8, pa3);
#undef PK4
}
template <int MODE>
__device__ __forceinline__ void qkt(f32x16& p0, f32x16& p1, const char* Ks, const char* K2s, const char* Q2s, const bf16x8* qr, int r32, int hi) {
#pragma unroll
    for (int r = 0; r < 16; ++r) { p0[r] = 0.f; p1[r] = 0.f; }
#pragma unroll
    for (int d0 = 0; d0 < 8; ++d0) { const int cb = (d0 * 16 + hi * 8) * 2;
        const bf16x8 b0 = *reinterpret_cast<const bf16x8*>(Ks + KSWZ(r32, cb));
        const bf16x8 b1 = *reinterpret_cast<const bf16x8*>(Ks + KSWZ(32 + r32, cb));
        p0 = __builtin_amdgcn_mfma_f32_32x32x16_bf16(b0, qr[d0], p0, 0, 0, 0);
        p1 = __builtin_amdgcn_mfma_f32_32x32x16_bf16(b1, qr[d0], p1, 0, 0, 0); }
    if constexpr (MODE == 0) {
#pragma unroll
        for (int d0 = 0; d0 < 4; ++d0) { const int cb = (d0 * 16 + hi * 8) * 2;
            const bf16x8 b0 = *reinterpret_cast<const bf16x8*>(K2s + K2SWZ(r32, cb));
            const bf16x8 b1 = *reinterpret_cast<const bf16x8*>(K2s + K2SWZ(32 + r32, cb));
            p0 = __builtin_amdgcn_mfma_f32_32x32x16_bf16(b0, qr[(MODE == 0 ? 8 : 0) + d0], p0, 0, 0, 0);
            p1 = __builtin_amdgcn_mfma_f32_32x32x16_bf16(b1, qr[(MODE == 0 ? 8 : 0) + d0], p1, 0, 0, 0); }
    }
}
__device__ __forceinline__ int v_st(int k, int c) { const int kk = (k & ~0xC) | ((k & 4) << 1) | ((k & 8) >> 1); return ((kk >> 3) * 4 + (c >> 5)) * 512 + ((kk & 7) * 32 + (c & 31)) * 2; }
__device__ __forceinline__ int v_rd_base(int lane) { return ((lane & 3) << 3) | (((lane >> 2) & 3) << 6) | (((lane >> 4) & 1) << 5) | (((lane >> 5) & 1) << 8); }
constexpr int v_rd_off(int d0, int ks, int half) { return d0 * 512 + ks * 4096 + half * 2048; }
template <int OFF> __device__ __forceinline__ s16x4 tr_read(int vb) {
    s16x4 r; asm volatile("ds_read_b64_tr_b16 %0, %1 offset:%2" : "=&v"(r) : "v"(vb), "i"(OFF) : "memory"); return r;
}
template <int D0> __device__ __forceinline__ void pv_one(f32x16& od, int vb, bf16x8 pa0, bf16x8 pa1, bf16x8 pa2, bf16x8 pa3) {
    const s16x4 l0 = tr_read<v_rd_off(D0, 0, 0)>(vb), h0 = tr_read<v_rd_off(D0, 0, 1)>(vb), l1 = tr_read<v_rd_off(D0, 1, 0)>(vb), h1 = tr_read<v_rd_off(D0, 1, 1)>(vb);
    const s16x4 l2 = tr_read<v_rd_off(D0, 2, 0)>(vb), h2 = tr_read<v_rd_off(D0, 2, 1)>(vb), l3 = tr_read<v_rd_off(D0, 3, 0)>(vb), h3 = tr_read<v_rd_off(D0, 3, 1)>(vb);
    asm volatile("s_waitcnt lgkmcnt(0)" ::: "memory"); SBAR();
#define PKV(L, H) (bf16x8){L[0], L[1], L[2], L[3], H[0], H[1], H[2], H[3]}
    od = __builtin_amdgcn_mfma_f32_32x32x16_bf16(pa0, PKV(l0, h0), od, 0, 0, 0);
    od = __builtin_amdgcn_mfma_f32_32x32x16_bf16(pa1, PKV(l1, h1), od, 0, 0, 0);
    od = __builtin_amdgcn_mfma_f32_32x32x16_bf16(pa2, PKV(l2, h2), od, 0, 0, 0);
    od = __builtin_amdgcn_mfma_f32_32x32x16_bf16(pa3, PKV(l3, h3), od, 0, 0, 0);
#undef PKV
}
__device__ __forceinline__ void pv_d0(f32x16* o, int vb, bf16x8 pa0, bf16x8 pa1, bf16x8 pa2, bf16x8 pa3) {
    pv_one<0>(o[0], vb, pa0, pa1, pa2, pa3); pv_one<1>(o[1], vb, pa0, pa1, pa2, pa3); pv_one<2>(o[2], vb, pa0, pa1, pa2, pa3); pv_one<3>(o[3], vb, pa0, pa1, pa2, pa3);
}
__device__ __forceinline__ void na_fix(f32x16& p0, f32x16& p1, const char* tbl, int tile_row, int rq, int rs_row, int tcol, unsigned mask0, unsigned mask1) {
    const bool tv = (tile_row >= rs_row) && (tile_row < rs_row + 8);
    if (tv) {
        const int dr = tile_row - rq + 7;
        const float* tb = (const float*)(tbl) + dr * 128 + tcol;
#pragma unroll
        for (int r = 0; r < 16; ++r) { const int o = (r & 3) + 8 * (r >> 2);
            const float b0 = tb[o], b1 = tb[o + 32];
            p0[r] = ((mask0 >> r) & 1u) ? p0[r] + b0 : -3e30f;
            p1[r] = ((mask1 >> r) & 1u) ? p1[r] + b1 : -3e30f; }
    } else {
#pragma unroll
        for (int r = 0; r < 16; ++r) { p0[r] = -3e30f; p1[r] = -3e30f; }
    }
}

template <int MODE>
__device__ __forceinline__ void attn_body(const bf16_t* __restrict__ Qb, const bf16_t* __restrict__ Kh, const bf16_t* __restrict__ Vh, const bf16_t* __restrict__ K2h,
                                          bf16_t* __restrict__ Ob, const int NT, const int na_lo, const int na_r0, const float* __restrict__ rpb_h, char* lds) {
    using CF = ACfg<MODE>;
    constexpr int LDQ = CF::LDQ, LDK = CF::LDK, LDV = CF::LDV, SDEPTH = CF::SDEPTH;
    const int tid = opq_tid(), wid = tid >> 6, lane = tid & 63, r32 = lane & 31, hi = lane >> 5;
    char* V_lds = lds + AOFF_V; char* K_lds = lds + AOFF_K; char* K2_lds = lds + AOFF_K2; char* tbl = lds + AOFF_TBL;
    float* ws = (float*)(lds + AOFF_WS) + wid * 64; float* li_l = ws; float* al_l = ws + 32;
    __syncthreads();
    int rq = 0, rs_row = 0, tcol = 0; unsigned mask0 = 0, mask1 = 0;
    if constexpr (MODE == 1) {
        for (int i = tid; i < 15 * 128; i += 512) { const int dr = i >> 7, t = (i & 127) - 63; const int dc = (t < -15 ? -15 : (t > 15 ? 15 : t)) + 15;
            ((float*)tbl)[i] = rpb_h[dr * 31 + dc] * (1.0f / CF::SCALE); }
        rq = na_r0 + (wid >> 1); rs_row = rq - 4 < 0 ? 0 : (rq - 4 > 24 ? 24 : rq - 4);
        const int cq = (wid & 1) * 32 + r32; const int cs = cq - 8 < 0 ? 0 : (cq - 8 > 48 ? 48 : cq - 8);
        tcol = 63 - cq + 4 * hi;
#pragma unroll
        for (int r = 0; r < 16; ++r) { const int ck = crow(r, hi);
            mask0 |= ((unsigned)(ck - cs) < 16u ? 1u : 0u) << r; mask1 |= ((unsigned)(ck + 32 - cs) < 16u ? 1u : 0u) << r; }
    }
    float m_reg = -1e30f, l_reg = 0;
    f32x16 o[4];
#pragma unroll
    for (int d = 0; d < 4; ++d)
#pragma unroll
        for (int r = 0; r < 16; ++r) o[d][r] = 0.f;
    bf16x8 qr[CF::ND0];
    const bf16_t* Qw = Qb + (long)(wid * 32 + r32) * LDQ + hi * 8;
#pragma unroll
    for (int d0 = 0; d0 < CF::ND0; ++d0) qr[d0] = *reinterpret_cast<const bf16x8*>(Qw + d0 * 16);
    char* Q2_lds = lds + AOFF_Q2 + wid * 4096;
    const int sr = tid >> 4, sc = (tid & 15) * 8, vst0 = v_st(sr, sc), vst1 = v_st(32 + sr, sc);
    const int s2r = tid >> 3, s2c = (tid & 7) * 8;
    const int vb0 = (int)(uintptr_t)V_lds + v_rd_base(lane);
    struct { bf16x8 vs0, vs1, ks0, ks1, k2; } sr_[SDEPTH];
#define TK0(tile) (MODE == 1 ? ((na_lo + (tile)) > 31 ? 31 : (na_lo + (tile))) * 64 : (tile) * KVBLK)
#define SLOAD(i, tile) do { const long k0_ = TK0(tile); sr_[i].vs0 = *reinterpret_cast<const bf16x8*>(&Vh[(k0_ + sr) * LDV + sc]); sr_[i].vs1 = *reinterpret_cast<const bf16x8*>(&Vh[(k0_ + 32 + sr) * LDV + sc]); \
    sr_[i].ks0 = *reinterpret_cast<const bf16x8*>(&Kh[(k0_ + sr) * LDK + sc]); sr_[i].ks1 = *reinterpret_cast<const bf16x8*>(&Kh[(k0_ + 32 + sr) * LDK + sc]); \
    if constexpr (MODE == 0) sr_[i].k2 = *reinterpret_cast<const bf16x8*>(&K2h[(k0_ + s2r) * 64 + s2c]); } while (0)
#define SWRITE(b, i) do { *(bf16x8*)(V_lds + (b) * SHM_V + vst0) = sr_[i].vs0; *(bf16x8*)(V_lds + (b) * SHM_V + vst1) = sr_[i].vs1; const int kc = sc * 2; \
    *(bf16x8*)(K_lds + (b) * SHM_K + KSWZ(sr, kc)) = sr_[i].ks0; *(bf16x8*)(K_lds + (b) * SHM_K + KSWZ(32 + sr, kc)) = sr_[i].ks1; \
    if constexpr (MODE == 0) *(bf16x8*)(K2_lds + (b) * SHM_K2 + K2SWZ(s2r, s2c * 2)) = sr_[i].k2; } while (0)
#define SWAIT() do { if constexpr (SDEPTH == 2) { if constexpr (MODE == 0) asm volatile("s_waitcnt vmcnt(5)" ::: "memory"); else asm volatile("s_waitcnt vmcnt(4)" ::: "memory"); } else asm volatile("s_waitcnt vmcnt(0)" ::: "memory"); } while (0)
#define RESC(a) do { if (__any((a) < 1.f)) { if (hi == 0) al_l[r32] = (a); asm volatile("s_waitcnt lgkmcnt(0)" ::: "memory"); \
    _Pragma("unroll") for (int d = 0; d < 4; ++d) _Pragma("unroll") for (int r = 0; r < 16; ++r) o[d][r] *= al_l[crow(r, hi)]; } } while (0)
#define NAFIX(P0, P1, tile) do { if constexpr (MODE == 1) na_fix(P0, P1, tbl, na_lo + (tile), rq, rs_row, tcol, mask0, mask1); } while (0)
    f32x16 pA0, pA1; float mnA, alA; bf16x8 pa0, pa1, pa2, pa3;
    SLOAD(0, 0); asm volatile("s_waitcnt vmcnt(0)" ::: "memory"); SWRITE(0, 0); __syncthreads();
    for (int j = 0; j < NT; ++j) {
        const int bsel = j & 1;
        if (j + 1 < NT) SLOAD(0, j + 1);
        SBAR();
        bool tile_on = true;
        if constexpr (MODE == 1) { const int trow = na_lo + j; tile_on = (trow >= rs_row) && (trow < rs_row + 8); }
        if (tile_on) {
            qkt<MODE>(pA0, pA1, K_lds + bsel * SHM_K, K2_lds + bsel * SHM_K2, Q2_lds, qr, r32, hi); NAFIX(pA0, pA1, j);
            partialSM<MODE>(pA0, pA1, m_reg, mnA, alA);
            RESC(alA);
            finishSM(pA0, pA1, alA, l_reg, pa0, pa1, pa2, pa3); SBAR();
            pv_d0(o, vb0 + bsel * (int)SHM_V, pa0, pa1, pa2, pa3);
        }
        if (j + 1 < NT) { asm volatile("s_waitcnt vmcnt(0)" ::: "memory"); SWRITE(bsel ^ 1, 0); }
        __syncthreads();
    }
    if (hi == 0) li_l[r32] = l_reg; asm volatile("s_waitcnt lgkmcnt(0)" ::: "memory");
    bf16_t* Ow = Ob + (long)(wid * 32) * 2048;
#pragma unroll
    for (int r = 0; r < 16; ++r) { const int orow = crow(r, hi); const float rl = __builtin_amdgcn_rcpf(li_l[orow]);
        const unsigned w01 = cvt_pk_bf16(o[0][r] * rl, o[1][r] * rl), w23 = cvt_pk_bf16(o[2][r] * rl, o[3][r] * rl);
        bf16_t* op = Ow + (long)orow * 2048 + r32;
        op[0] = (bf16_t)(w01 & 0xffffu); op[32] = (bf16_t)(w01 >> 16); op[64] = (bf16_t)(w23 & 0xffffu); op[96] = (bf16_t)(w23 >> 16); }
#undef TK0
#undef SLOAD
#undef SWRITE
#undef SWAIT
#undef RESC
#undef NAFIX
}


#define XB_TMO      128
#define XB_XCNT(j)  (256  + 64 * (j))
#define XB_XSUB(j)  (1280 + 64 * (j))
#define XB_XGEN(j)  (2304 + 64 * (j))
#define XB_TOP      3328
#define XB_TOPGEN   3392
#define XCD_BAR_WORDS 3456
#define XB_SPIN_CAP (1u << 22)
static_assert(XCD_BAR_WORDS * 4 <= SZ_BAR, "barrier words");
__device__ __forceinline__ unsigned xb_ld(unsigned* p)              { return __hip_atomic_load(p, __ATOMIC_RELAXED, __HIP_MEMORY_SCOPE_AGENT); }
__device__ __forceinline__ unsigned xb_add(unsigned* p, unsigned v) { return __hip_atomic_fetch_add(p, v, __ATOMIC_RELAXED, __HIP_MEMORY_SCOPE_AGENT); }
__device__ __forceinline__ unsigned xb_xcc_id() { return (unsigned)__builtin_amdgcn_s_getreg((3 << 11) | 20) & 0xFu; }
#define XB_SPIN(cond, bar) do { unsigned _sp = 0; while (cond) { __builtin_amdgcn_s_sleep(1); \
    if ((++_sp & 255u) == 0u) { if (xb_ld(&(bar)[XB_TMO])) break; if (_sp > XB_SPIN_CAP) { atomicAdd(&(bar)[XB_TMO], 1u); break; } } } } while (0)
struct XcdBarrier { unsigned* bar; unsigned x; volatile LAS unsigned* st; };
__device__ __forceinline__ XcdBarrier xcd_barrier_post(unsigned* bar, volatile LAS unsigned* st) {
    XcdBarrier b; b.bar = bar; b.x = xb_xcc_id(); b.st = st;
    if (threadIdx.x == 0) (void)xb_add(&bar[XB_XCNT(b.x)], 1u);
    return b;
}
__device__ __forceinline__ void xcd_barrier_complete(unsigned* bar, unsigned x, unsigned& nloc, unsigned& nx) {
    const unsigned G = gridDim.x * gridDim.y * gridDim.z;
    unsigned sum, cnt, mine, sp = 0u;
    for (;;) {
        sum = 0u; cnt = 0u; mine = 0u;
#pragma unroll
        for (unsigned j = 0; j < 16; ++j) { const unsigned c = xb_ld(&bar[XB_XCNT(j)]); sum += c; cnt += (c > 0u) ? 1u : 0u; mine = (j == x) ? c : mine; }
        if (sum == G) break;
        __builtin_amdgcn_s_sleep(1);
        if ((++sp & 255u) == 0u) { if (xb_ld(&bar[XB_TMO])) break; if (sp > XB_SPIN_CAP) { atomicAdd(&bar[XB_TMO], 1u); break; } }
    }
    nloc = mine > 0u ? mine : 1u; nx = cnt > 0u ? cnt : 1u;
}
__device__ __forceinline__ void xcd_barrier(const XcdBarrier& b) {
    asm volatile("s_waitcnt vmcnt(0)" ::: "memory");
    __syncthreads();
    if (threadIdx.x == 0) {
        unsigned* bar = b.bar;
        __builtin_amdgcn_s_waitcnt(0);
        unsigned nloc = b.st[0], nx = b.st[1];
        if (nloc == 0u) { xcd_barrier_complete(bar, b.x, nloc, nx); b.st[0] = nloc; b.st[1] = nx; }
        const unsigned old = xb_add(&bar[XB_XSUB(b.x)], 1u);
        const unsigned gen = old / nloc;
        if (old + 1u == (gen + 1u) * nloc) {
            __builtin_amdgcn_fence(__ATOMIC_RELEASE, "agent");
            asm volatile("s_waitcnt vmcnt(0)" ::: "memory");
            const unsigned og = xb_add(&bar[XB_TOP], 1u);
            const unsigned tg = og / nx;
            if (og + 1u == (tg + 1u) * nx) xb_add(&bar[XB_TOPGEN], 1u);
            else XB_SPIN(xb_ld(&bar[XB_TOPGEN]) == tg, bar);
            __builtin_amdgcn_fence(__ATOMIC_ACQUIRE, "agent");
            xb_add(&bar[XB_XGEN(b.x)], 1u);
            asm volatile("s_waitcnt vmcnt(0)" ::: "memory");
        } else {
            XB_SPIN(xb_ld(&bar[XB_XGEN(b.x)]) == gen, bar);
            __builtin_amdgcn_fence(__ATOMIC_ACQUIRE, "agent");
            asm volatile("s_waitcnt vmcnt(0)" ::: "memory");
        }
    }
    __syncthreads();
}

constexpr size_t LDS_BYTES = STAGE_BYTES + 64;
static_assert(ATT_LDS_END <= LDS_BYTES, "attention LDS");

__device__ __forceinline__ void phase1(const Params& P, char* lds) {
    GSched S; S.init(P.ws + OFF_HB + 512, P.ws + OFF_WGU, 64, 44, nullptr, nullptr, 0);
    EpiSwiglu E; E.mid_t = 0; E.act = (bf16_t*)(P.ws + OFF_ACT); E.part = (const float*)(P.ws + OFF_PART0);
    gemm_phase(( LAS unsigned char*)lds, S, 2048, LDHB, LDB2K, E);
}
__device__ __forceinline__ void phase2(const Params& P, char* lds) {
    GSched S; S.init(P.ws + OFF_ACT, P.ws + OFF_WD, 64, 8, nullptr, nullptr, 0);
    EpiResid<true> E; E.mid_t = 0; E.hin = P.x; E.hb = (bf16_t*)(P.ws + OFF_HB); E.part = (float*)(P.ws + OFF_PART0 + SZ_PART); E.scale = 0.5f;
    gemm_phase((LAS unsigned char*)lds, S, 5632, LDACT, LDWD, E);
}
__device__ __forceinline__ void phase3(const Params& P, char* lds) {
    GSched S; S.init(P.ws + OFF_HB + 512, P.ws + OFF_WIN, 64, 16, nullptr, nullptr, 0);
    EpiWin E; E.mid_t = 0; E.qkv = (bf16_t*)(P.ws + OFF_QKV); E.lat = (bf16_t*)(P.ws + OFF_LAT); E.latpart = (float*)(P.ws + OFF_LATPART); E.part = (const float*)(P.ws + OFF_PART0 + SZ_PART);
    gemm_phase((LAS unsigned char*)lds, S, 2048, LDHB, LDB2K, E);
}
__device__ __forceinline__ void phase4(const Params& P, char* lds) {
    {
        GSched S; S.init(P.ws + OFF_LAT, P.ws + OFF_WUQ, 64, 6, P.ws + OFF_LAT + 1024, P.ws + OFF_WUKV, 8);
        if (gridDim.x == 256) S.cut = 192;
        EpiUp E; E.mid_t = 0; E.q = (bf16_t*)(P.ws + OFF_Q); E.kv = (bf16_t*)(P.ws + OFF_KV); E.latpart = (const float*)(P.ws + OFF_LATPART);
        E.rc = (const float*)(P.ws + OFF_ROPEC); E.rsn = (const float*)(P.ws + OFF_ROPES);
        gemm_phase((LAS unsigned char*)lds, S, 512, 1024, 512, E);
    }
    {
        GSched S; S.init(P.ws + OFF_HB + 512, P.ws + OFF_WIN + 8192ull * LDB2K * 2, 64, 1, nullptr, nullptr, 0);
        S.c = (int)gridDim.x - 1 - (int)blockIdx.x;
        EpiKrope E; E.mid_t = 0; E.krope = (bf16_t*)(P.ws + OFF_KROPE); E.part = (const float*)(P.ws + OFF_PART0 + SZ_PART);
        E.rc = (const float*)(P.ws + OFF_ROPEC); E.rsn = (const float*)(P.ws + OFF_ROPES);
        gemm_phase((LAS unsigned char*)lds, S, 2048, LDHB, LDB2K, E);
    }
    {
        const bf16_t* qkv = (const bf16_t*)(P.ws + OFF_QKV); bf16_t* att = (bf16_t*)(P.ws + OFF_ATT);
        for (int u = blockIdx.x; u < 512; u += gridDim.x) {
            const int b = u >> 6, h = (u >> 3) & 7, r0 = (u & 7) * 4;
            const int lo = r0 - 4 < 0 ? 0 : (r0 - 4 > 24 ? 24 : r0 - 4);
            const int r3 = r0 + 3 - 4; const int hi_row = (r3 < 0 ? 0 : (r3 > 24 ? 24 : r3)) + 7;
            const int NT = hi_row - lo + 1;
            const size_t tok0 = (size_t)b * SEQ;
            attn_body<1>(qkv + (tok0 + r0 * 64) * 3072 + h * 128, qkv + tok0 * 3072 + 1024 + h * 128, qkv + tok0 * 3072 + 2048 + h * 128, nullptr,
                         att + (tok0 + r0 * 64) * 2048 + h * 128, NT, lo, r0, P.na_rpb + h * 15 * 31, lds);
        }
    }
}
__device__ __forceinline__ void phase5(const Params& P, char* lds) {
    { int cvt_base = 0; CVT_JOB(11); CVT_JOB(12); CVT_JOB(13); __syncthreads(); }
    {
        GSched S; S.init(P.ws + OFF_HB + 512, P.ws + OFF_WIN + 4096ull * LDB2K * 2, 64, 16, nullptr, nullptr, 0);
        EpiGates E; E.mid_t = 0; E.gates = (bf16_t*)(P.ws + OFF_GATES); E.part = (const float*)(P.ws + OFF_PART0 + SZ_PART);
        gemm_phase((LAS unsigned char*)lds, S, 2048, LDHB, LDB2K, E);
    }
    {
        const bf16_t* q = (const bf16_t*)(P.ws + OFF_Q); const bf16_t* kv = (const bf16_t*)(P.ws + OFF_KV); const bf16_t* kr = (const bf16_t*)(P.ws + OFF_KROPE); bf16_t* att = (bf16_t*)(P.ws + OFF_ATT);
        for (int u = blockIdx.x; u < 512; u += gridDim.x) {
            const int b = u >> 6, h = (u >> 3) & 7, qb = u & 7;
            const size_t tok0 = (size_t)b * SEQ;
            attn_body<0>(q + (tok0 + qb * 256) * 1536 + h * 192, kv + tok0 * 2048 + h * 256, kv + tok0 * 2048 + h * 256 + 128, kr + tok0 * 64,
                         att + (tok0 + qb * 256) * 2048 + 1024 + h * 128, SEQ / KVBLK, 0, 0, nullptr, lds);
        }
    }
}
__device__ __forceinline__ void phase6(const Params& P, char* lds) {
    GSched S; S.init(P.ws + OFF_ATT, P.ws + OFF_WAB, 64, 8, nullptr, nullptr, 0);
    EpiMerge E; E.mid_t = 16; E.merged = (bf16_t*)(P.ws + OFF_MERGED); E.gates = (const bf16_t*)(P.ws + OFF_GATES);
    gemm_phase((LAS unsigned char*)lds, S, 2048, 2048, LDB2K, E);
}
__device__ __forceinline__ void phase7(const Params& P, char* lds) {
    GSched S; S.init(P.ws + OFF_MERGED, P.ws + OFF_WOUT, 64, 8, nullptr, nullptr, 0);
    EpiResid<false> E; E.mid_t = 0; E.hin = nullptr; E.hb = (bf16_t*)(P.ws + OFF_HB); E.part = (float*)(P.ws + OFF_PART0 + 2 * SZ_PART); E.scale = 1.0f;
    gemm_phase((LAS unsigned char*)lds, S, 2048, 2048, LDB2K, E);
}
__device__ __forceinline__ void phase8(const Params& P, char* lds) {
    GSched S; S.init(P.ws + OFF_HB + 512, P.ws + OFF_WGU, 64, 44, nullptr, nullptr, 0);
    EpiSwiglu E; E.mid_t = 0; E.act = (bf16_t*)(P.ws + OFF_ACT); E.part = (const float*)(P.ws + OFF_PART0 + 2 * SZ_PART);
    gemm_phase((LAS unsigned char*)lds, S, 2048, LDHB, LDB2K, E);
}
__device__ __forceinline__ void phase9(const Params& P, char* lds) {
    GSched S; S.init(P.ws + OFF_ACT, P.ws + OFF_WD, 64, 8, nullptr, nullptr, 0);
    EpiResid<false> E; E.mid_t = 0; E.hin = nullptr; E.hb = (bf16_t*)(P.ws + OFF_HB); E.part = (float*)(P.ws + OFF_PART0 + 3 * SZ_PART); E.scale = 0.5f;
    gemm_phase((LAS unsigned char*)lds, S, 5632, LDACT, LDWD, E);
}
__device__ __forceinline__ void phase10(const Params& P, char* lds) {
    GSched S; S.init(P.ws + OFF_HB, P.ws + OFF_WPL, 64, 8, nullptr, nullptr, 0);
    EpiPl E; E.mid_t = 4; E.h4b = (bf16_t*)(P.ws + OFF_KV); E.hb = (const bf16_t*)(P.ws + OFF_HB); E.etmp = (bf16_t*)(P.ws + OFF_ETMP); E.part_in = (const float*)(P.ws + OFF_PART0 + 3 * SZ_PART); E.part_out = (float*)(P.ws + OFF_PART0 + 4 * SZ_PART);
    gemm_phase((LAS unsigned char*)lds, S, 2304, LDHB, 2304, E);
}
__device__ __forceinline__ void phase11(const Params& P, char* lds) {
    const int tid = opq_tid(), wid = tid >> 6, lane = tid & 63;
    const float* part = (const float*)(P.ws + OFF_PART0 + 4 * SZ_PART);
    const bf16_t* h4b = (const bf16_t*)(P.ws + OFF_KV);
    for (int row = blockIdx.x * 8 + wid; row < T; row += gridDim.x * 8) {
        float s = lane < 32 ? part[(size_t)row * 32 + lane] : 0.f;
        const bf16_t* hr = h4b + (size_t)row * DM; float* orow = P.H + (size_t)row * DM;
        u32x4 hv[4];
#pragma unroll
        for (int j = 0; j < 4; ++j) hv[j] = ld_nt(hr + j * 512 + lane * 8);
#pragma unroll
        for (int o = 16; o >= 1; o >>= 1) s += __shfl_xor(s, o);
        s = __shfl(s, 0);
        const float rs = __builtin_amdgcn_rsqf(s * (1.0f / 2048.0f) + EPS);
#pragma unroll
        for (int j = 0; j < 4; ++j) { const int c = j * 512 + lane * 8; f32x4 a, b; unpack8(hv[j], a, b);
            const f32x4 g0 = *(const f32x4*)(P.final_norm + c), g1 = *(const f32x4*)(P.final_norm + c + 4);
            st_nt(orow + c, a * rs * g0); st_nt(orow + c + 4, b * rs * g1); }
    }
}

typedef __attribute__((address_space(4))) const Params* KArgPtr;
template <int PH> __device__ __forceinline__ void run_phase(char* lds) {
#if defined(__HIP_DEVICE_COMPILE__)
    KArgPtr kp = (KArgPtr)__builtin_amdgcn_kernarg_segment_ptr(); asm volatile("" : "+s"(kp));
    const Params P = *kp;
#else
    const Params P{};
#endif
    if constexpr (PH == 0) phase0(P, lds);
    if constexpr (PH == 1) phase1(P, lds);
    if constexpr (PH == 2) phase2(P, lds);
    if constexpr (PH == 3) phase3(P, lds);
    if constexpr (PH == 4) phase4(P, lds);
    if constexpr (PH == 5) phase5(P, lds);
    if constexpr (PH == 6) phase6(P, lds);
    if constexpr (PH == 7) phase7(P, lds);
    if constexpr (PH == 8) phase8(P, lds);
    if constexpr (PH == 9) phase9(P, lds);
    if constexpr (PH == 10) phase10(P, lds);
    if constexpr (PH == 11) phase11(P, lds);
}

#if MEGA
__global__ __launch_bounds__(512, 2) void fwd_megakernel(Params P) {
    extern __shared__ __attribute__((aligned(16))) char shm[];
    cg::grid_group grid = cg::this_grid();
    volatile LAS unsigned* st = (volatile LAS unsigned*)(shm + STAGE_BYTES);
    if (threadIdx.x == 0) { st[0] = 0u; st[1] = 0u; }
    __syncthreads();
    if (blockIdx.x == 0) { unsigned* bw = (unsigned*)(P.ws + OFF_BAR); for (int i = threadIdx.x; i < XCD_BAR_WORDS; i += 512) __hip_atomic_store(bw + i, 0u, __ATOMIC_RELAXED, __HIP_MEMORY_SCOPE_AGENT); }
    run_phase<0>(shm); asm volatile("s_waitcnt vmcnt(0)" ::: "memory"); __syncthreads(); grid.sync();
    const XcdBarrier xb = xcd_barrier_post((unsigned*)(P.ws + OFF_BAR), st);
    run_phase<1>(shm); xcd_barrier(xb);
    run_phase<2>(shm); xcd_barrier(xb);
    run_phase<3>(shm); xcd_barrier(xb);
    run_phase<4>(shm); xcd_barrier(xb);
    run_phase<5>(shm); xcd_barrier(xb);
    run_phase<6>(shm); xcd_barrier(xb);
    run_phase<7>(shm); xcd_barrier(xb);
    run_phase<8>(shm); xcd_barrier(xb);
    run_phase<9>(shm); xcd_barrier(xb);
    run_phase<10>(shm); xcd_barrier(xb);
    run_phase<11>(shm);
}
#else
template <int PH> __global__ __launch_bounds__(512, 2) void k_phase(Params P) {
    extern __shared__ __attribute__((aligned(16))) char shm[];
    run_phase<PH>(shm);
}
template <int PH> static void launch_phase(const Params& P, hipStream_t stream) {
    hipFuncSetAttribute((const void*)k_phase<PH>, hipFuncAttributeMaxDynamicSharedMemorySize, (int)LDS_BYTES);
    hipLaunchKernelGGL(k_phase<PH>, dim3(256), dim3(512), LDS_BYTES, stream, P);
}
#endif

extern "C" void kernel_launch(void* const* d_in, const int* in_sizes, int n_in, void* d_out, int out_size, void* d_ws, size_t ws_size, hipStream_t stream) {
    (void)in_sizes; (void)out_size;
    if (n_in != 24 || ws_size < WS_END) { fprintf(stderr, "kernel_launch: unexpected n_in %d or ws_size %zu (need %zu)\n", n_in, ws_size, (size_t)WS_END); return; }
    Params P{};
    const float** f = (const float**)&P;
    for (int i = 0; i < 24; ++i) f[i] = (const float*)d_in[i];
    P.H = (float*)d_out; P.ws = (char*)d_ws;
#if MEGA
    static int grid_blocks = 0;
    if (!grid_blocks) {
        hipFuncSetAttribute((const void*)fwd_megakernel, hipFuncAttributeMaxDynamicSharedMemorySize, (int)LDS_BYTES);
        int dev = 0, cus = 0, per_cu = 0;
        hipGetDevice(&dev);
        hipDeviceGetAttribute(&cus, hipDeviceAttributeMultiprocessorCount, dev);
        hipOccupancyMaxActiveBlocksPerMultiprocessor(&per_cu, fwd_megakernel, 512, LDS_BYTES);
        if (per_cu < 1) per_cu = 1;
        grid_blocks = cus < 256 ? cus : 256;
    }
    void* args[] = {&P};
    hipError_t e = hipLaunchCooperativeKernel((void*)fwd_megakernel, dim3(grid_blocks), dim3(512), args, LDS_BYTES, stream);
    if (e != hipSuccess) fprintf(stderr, "cooperative launch failed: %s (grid %d)\n", hipGetErrorString(e), grid_blocks);
#else
    launch_phase<0>(P, stream); launch_phase<1>(P, stream); launch_phase<2>(P, stream); launch_phase<3>(P, stream);
    launch_phase<4>(P, stream); launch_phase<5>(P, stream); launch_phase<6>(P, stream); launch_phase<7>(P, stream);
    launch_phase<8>(P, stream); launch_phase<9>(P, stream); launch_phase<10>(P, stream); launch_phase<11>(P, stream);
#endif
}
```

```cpp
#include <hip/hip_runtime.h>
#include <hip/hip_cooperative_groups.h>
#include <cstdio>
#include <cstdint>
namespace cg = cooperative_groups;

#ifndef MEGA
#define MEGA 1
#endif

#define LAS __attribute__((address_space(3)))
typedef unsigned short bf16_t;
typedef short bf16x8 __attribute__((ext_vector_type(8)));
typedef short s16x4 __attribute__((ext_vector_type(4)));
typedef float f32x4 __attribute__((ext_vector_type(4)));
typedef float f32x16 __attribute__((ext_vector_type(16)));
typedef unsigned u32x4 __attribute__((ext_vector_type(4)));
typedef unsigned u32x2 __attribute__((ext_vector_type(2)));

constexpr int T = 16384, DM = 2048, DFF = 5632, SEQ = 2048;
constexpr int LDHB = 2368;
constexpr float EPS = 1e-6f;
constexpr int LDACT = 5696, LDWD = 5696;
constexpr int LDB2K = 2112;

constexpr size_t SZ_WUQ = 1536ull * 512 * 2, SZ_WUKV = 2048ull * 512 * 2, SZ_WAB = 2048ull * LDB2K * 2, SZ_WOUT = SZ_WAB, SZ_WPL = 2048ull * 2304 * 2;
constexpr size_t OFF_WUQ = 0, OFF_WUKV = OFF_WUQ + SZ_WUQ, OFF_WAB = OFF_WUKV + SZ_WUKV, OFF_WOUT = OFF_WAB + SZ_WAB, OFF_WPL = OFF_WOUT + SZ_WOUT;
constexpr size_t OFF_HB = OFF_WPL + SZ_WPL, SZ_HB = (size_t)T * LDHB * 2;
constexpr size_t OFF_C = OFF_HB + SZ_HB, SZ_C = (size_t)T * LDACT * 2;
constexpr size_t OFF_ACT = OFF_C, OFF_QKV = OFF_C, OFF_LAT = OFF_C + (size_t)T * 3072 * 2, OFF_GATES = OFF_C, OFF_Q = OFF_C + (size_t)T * 4096 * 2, OFF_ETMP = OFF_C;
constexpr size_t OFF_KV = OFF_C + SZ_C, OFF_MERGED = OFF_KV, OFF_ATT = OFF_KV + (size_t)T * 2048 * 2, OFF_KROPE = OFF_ATT + (size_t)T * 2048 * 2;
constexpr size_t OFF_WGU = OFF_KROPE + (size_t)T * 64 * 2, SZ_WGU = 11264ull * LDB2K * 2, OFF_WD = OFF_WGU + SZ_WGU, SZ_WD = 2048ull * LDWD * 2;
constexpr size_t OFF_WIN = OFF_WD + SZ_WD, SZ_WIN = 8448ull * LDB2K * 2;
constexpr size_t SZ_PART = (size_t)T * 32 * 4;
constexpr size_t OFF_PART0 = OFF_WIN + SZ_WIN, OFF_LATPART = OFF_PART0 + 5 * SZ_PART, OFF_ROPEC = OFF_LATPART + (size_t)T * 16 * 4, OFF_ROPES = OFF_ROPEC + 2048 * 32 * 4;
constexpr size_t OFF_BAR = OFF_ROPES + 2048 * 32 * 4, SZ_BAR = 16384;
constexpr size_t WS_END = OFF_BAR + SZ_BAR;
static_assert(WS_END <= 555280928ull, "workspace overflow");
static_assert(OFF_Q + (size_t)T * 1536 * 2 <= OFF_C + SZ_C, "q overlay");

struct Params {
    const float *x, *p, *ffn1_norm, *ffn1_wg, *ffn1_wu, *ffn1_wd, *mix_norm, *w_in, *q_a_norm, *w_uq, *kv_a_norm, *w_ukv, *na_rpb, *w_a, *w_b, *w_out,
        *ffn2_norm, *ffn2_wg, *ffn2_wu, *ffn2_wd, *pl_norm, *w_pl, *w_plg, *final_norm;
    float* H;
    char* ws;
};

__device__ __forceinline__ int opq_tid() { int t = threadIdx.x; asm volatile("" : "+v"(t)); return t; }
typedef __bf16 bf16x2_t __attribute__((ext_vector_type(2)));
typedef float f32x2_t __attribute__((ext_vector_type(2)));
__device__ __forceinline__ unsigned cvt_pk_bf16(float lo, float hi) { const f32x2_t v = {lo, hi}; const bf16x2_t r = __builtin_convertvector(v, bf16x2_t); return __builtin_bit_cast(unsigned, r); }
__device__ __forceinline__ f32x4 ld_nt(const float* p) { return __builtin_nontemporal_load((const f32x4*)p); }
__device__ __forceinline__ u32x4 ld_nt(const bf16_t* p) { return __builtin_nontemporal_load((const u32x4*)p); }
__device__ __forceinline__ void st_nt(float* p, f32x4 v) { __builtin_nontemporal_store(v, (f32x4*)p); }
__device__ __forceinline__ void st_nt(bf16_t* p, u32x4 v) { __builtin_nontemporal_store(v, (u32x4*)p); }
__device__ __forceinline__ float bf_lo(unsigned w) { return __uint_as_float(w << 16); }
__device__ __forceinline__ float bf_hi(unsigned w) { return __uint_as_float(w & 0xffff0000u); }
__device__ __forceinline__ float sigmoidf_(float v) { return __builtin_amdgcn_rcpf(1.0f + __builtin_amdgcn_exp2f(-1.4426950408889634f * v)); }

struct CvtJob { const float* src; bf16_t* dst; const float* gain; int ldsrc, Ks, Ns, Kd, koff, mode, param; };
__device__ __forceinline__ int map_col(int mode, int param, int n) {
    if (mode == 0) return n + param;
    if (mode == 1) return (n >> 7) * 256 + (n & 127) + param;
    if (mode == 2) { const int h = n / 192, o = n - h * 192; if (o < 128) return n; const int i = o - 128; return h * 192 + 128 + 8 * ((i & 31) >> 2) + 4 * (i >> 5) + (i & 3); }
    if (n < 4096) return n;
    if (n < 4160) { const int i = n - 4096; return 8192 + 8 * ((i & 31) >> 2) + 4 * (i >> 5) + (i & 3); }
    { const int g = n - 4160; const int isb = g >= 2048 ? 1 : 0; const int c = g - isb * 2048; return 4096 + (c >> 7) * 256 + isb * 128 + (c & 127); }
}
__device__ __forceinline__ CvtJob get_job(const Params& P, int j) {
    CvtJob J; J.gain = nullptr; J.koff = 0; J.mode = 0; J.param = 0;
    char* ws = P.ws;
    switch (j) {
    case 0: J.src = P.ffn1_wg; J.dst = (bf16_t*)(ws + OFF_WGU); J.gain = P.ffn1_norm; J.ldsrc = 5632; J.Ks = 2048; J.Ns = 5632; J.Kd = LDB2K; J.mode = 1; J.param = 0; break;
    case 1: J.src = P.ffn1_wu; J.dst = (bf16_t*)(ws + OFF_WGU); J.gain = P.ffn1_norm; J.ldsrc = 5632; J.Ks = 2048; J.Ns = 5632; J.Kd = LDB2K; J.mode = 1; J.param = 128; break;
    case 2: J.src = P.ffn1_wd; J.dst = (bf16_t*)(ws + OFF_WD); J.ldsrc = 2048; J.Ks = 5632; J.Ns = 2048; J.Kd = LDWD; break;
    case 3: J.src = P.w_in; J.dst = (bf16_t*)(ws + OFF_WIN); J.gain = P.mix_norm; J.ldsrc = 8256; J.Ks = 2048; J.Ns = 8256; J.Kd = LDB2K; J.mode = 3; break;
    case 4: J.src = P.w_uq; J.dst = (bf16_t*)(ws + OFF_WUQ); J.gain = P.q_a_norm; J.ldsrc = 1536; J.Ks = 512; J.Ns = 1536; J.Kd = 512; J.mode = 2; break;
    case 5: J.src = P.w_ukv; J.dst = (bf16_t*)(ws + OFF_WUKV); J.gain = P.kv_a_norm; J.ldsrc = 2048; J.Ks = 512; J.Ns = 2048; J.Kd = 512; break;
    case 6: J.src = P.w_a; J.dst = (bf16_t*)(ws + OFF_WAB); J.ldsrc = 2048; J.Ks = 1024; J.Ns = 2048; J.Kd = LDB2K; break;
    case 7: J.src = P.w_b; J.dst = (bf16_t*)(ws + OFF_WAB); J.ldsrc = 2048; J.Ks = 1024; J.Ns = 2048; J.Kd = LDB2K; J.koff = 1024; break;
    case 8: J.src = P.w_out; J.dst = (bf16_t*)(ws + OFF_WOUT); J.ldsrc = 2048; J.Ks = 2048; J.Ns = 2048; J.Kd = LDB2K; break;
    case 9: J.src = P.w_pl; J.dst = (bf16_t*)(ws + OFF_WPL); J.ldsrc = 2048; J.Ks = 256; J.Ns = 2048; J.Kd = 2304; break;
    case 10: J.src = P.w_plg; J.dst = (bf16_t*)(ws + OFF_WPL); J.gain = P.pl_norm; J.ldsrc = 2048; J.Ks = 2048; J.Ns = 2048; J.Kd = 2304; J.koff = 256; break;
    case 11: J.src = P.ffn2_wg; J.dst = (bf16_t*)(ws + OFF_WGU); J.gain = P.ffn2_norm; J.ldsrc = 5632; J.Ks = 2048; J.Ns = 5632; J.Kd = LDB2K; J.mode = 1; J.param = 0; break;
    case 12: J.src = P.ffn2_wu; J.dst = (bf16_t*)(ws + OFF_WGU); J.gain = P.ffn2_norm; J.ldsrc = 5632; J.Ks = 2048; J.Ns = 5632; J.Kd = LDB2K; J.mode = 1; J.param = 128; break;
    default: J.src = P.ffn2_wd; J.dst = (bf16_t*)(ws + OFF_WD); J.ldsrc = 2048; J.Ks = 5632; J.Ns = 2048; J.Kd = LDWD; break;
    }
    return J;
}
constexpr int CVT_LDW = 130;
__device__ __forceinline__ void convert_job(const CvtJob& J, int& base, char* lds) {
    unsigned* s = (unsigned*)lds;
    const int tid = opq_tid();
    {
        const int ntn = J.Ns >> 6, ntk = J.Ks >> 8, nt = ntn * ntk;
        const int first = ((int)blockIdx.x - base % (int)gridDim.x + (int)gridDim.x) % (int)gridDim.x;
        const int lk2 = tid >> 4, ln = (tid & 15) << 2;
        for (int t = first; t < nt; t += 2 * gridDim.x) {
            const int t1 = t + gridDim.x; const bool two = t1 < nt;
            const int tk0 = t / ntn, tn0 = t - tk0 * ntn, ka = tk0 << 8, na = tn0 << 6;
            const int tk1 = two ? t1 / ntn : tk0, tn1 = two ? t1 - tk1 * ntn : tn0, kb = tk1 << 8, nb = tn1 << 6;
            f32x4 va[4][2], vb[4][2];
#pragma unroll
            for (int i = 0; i < 4; ++i)
#pragma unroll
                for (int e2 = 0; e2 < 2; ++e2) va[i][e2] = ld_nt(J.src + (size_t)(ka + 64 * i + 2 * lk2 + e2) * J.ldsrc + na + ln);
            if (two) {
#pragma unroll
                for (int i = 0; i < 4; ++i)
#pragma unroll
                    for (int e2 = 0; e2 < 2; ++e2) vb[i][e2] = ld_nt(J.src + (size_t)(kb + 64 * i + 2 * lk2 + e2) * J.ldsrc + nb + ln);
            }
            if (J.gain) {
#pragma unroll
                for (int i = 0; i < 4; ++i) { const float g0 = J.gain[ka + 64 * i + 2 * lk2], g1 = J.gain[ka + 64 * i + 2 * lk2 + 1]; va[i][0] *= g0; va[i][1] *= g1; }
                if (two) {
#pragma unroll
                    for (int i = 0; i < 4; ++i) { const float g0 = J.gain[kb + 64 * i + 2 * lk2], g1 = J.gain[kb + 64 * i + 2 * lk2 + 1]; vb[i][0] *= g0; vb[i][1] *= g1; }
                }
            }
            __syncthreads();
#pragma unroll
            for (int i = 0; i < 4; ++i)
#pragma unroll
                for (int q = 0; q < 4; ++q) s[(ln + q) * CVT_LDW + 32 * i + lk2] = cvt_pk_bf16(va[i][0][q], va[i][1][q]);
            if (two) {
#pragma unroll
                for (int i = 0; i < 4; ++i)
#pragma unroll
                    for (int q = 0; q < 4; ++q) s[64 * CVT_LDW + (ln + q) * CVT_LDW + 32 * i + lk2] = cvt_pk_bf16(vb[i][0][q], vb[i][1][q]);
            }
            __syncthreads();
#pragma unroll
            for (int i = 0; i < 4; ++i) {
                const int id = tid + 512 * i, rn = id >> 5, rk = (id & 31) << 3;
                const u32x2 w0 = *(const u32x2*)(s + rn * CVT_LDW + (rk >> 1)), w1 = *(const u32x2*)(s + rn * CVT_LDW + (rk >> 1) + 2);
                const int dn = map_col(J.mode, J.param, na + rn);
                u32x4 w; w.x = w0.x; w.y = w0.y; w.z = w1.x; w.w = w1.y;
                *(u32x4*)(J.dst + (size_t)dn * J.Kd + J.koff + ka + rk) = w;
            }
            if (two) {
#pragma unroll
                for (int i = 0; i < 4; ++i) {
                    const int id = tid + 512 * i, rn = id >> 5, rk = (id & 31) << 3;
                    const u32x2 w0 = *(const u32x2*)(s + (64 + rn) * CVT_LDW + (rk >> 1)), w1 = *(const u32x2*)(s + (64 + rn) * CVT_LDW + (rk >> 1) + 2);
                    const int dn = map_col(J.mode, J.param, nb + rn);
                    u32x4 w; w.x = w0.x; w.y = w0.y; w.z = w1.x; w.w = w1.y;
                    *(u32x4*)(J.dst + (size_t)dn * J.Kd + J.koff + kb + rk) = w;
                }
            }
        }
        base += nt;
    }
}
#define CVT_JOB(j) do { const CvtJob J_ = get_job(P, j); convert_job(J_, cvt_base, lds); } while (0)

__device__ __forceinline__ void phase0(const Params& P, char* lds) {
    const int tid = opq_tid(), wid = tid >> 6, lane = tid & 63;
    const int G = gridDim.x;
    {
        bf16_t* hb = (bf16_t*)(P.ws + OFF_HB); float* part = (float*)(P.ws + OFF_PART0);
        for (int row = blockIdx.x * 8 + wid; row < T; row += G * 8) {
            const float* xr = P.x + (size_t)row * DM; float ss = 0.f;
#pragma unroll
            for (int j = 0; j < 4; ++j) {
                const int c = j * 512 + lane * 8;
                const f32x4 a = ld_nt(xr + c), b = ld_nt(xr + c + 4);
                ss += (a[0] * a[0] + a[1] * a[1]) + (a[2] * a[2] + a[3] * a[3]) + (b[0] * b[0] + b[1] * b[1]) + (b[2] * b[2] + b[3] * b[3]);
                u32x4 w; w.x = cvt_pk_bf16(a[0], a[1]); w.y = cvt_pk_bf16(a[2], a[3]); w.z = cvt_pk_bf16(b[0], b[1]); w.w = cvt_pk_bf16(b[2], b[3]);
                *(u32x4*)(hb + (size_t)row * LDHB + 256 + c) = w;
            }
#pragma unroll
            for (int o = 32; o >= 1; o >>= 1) ss += __shfl_xor(ss, o);
            if (lane < 32) part[(size_t)row * 32 + lane] = ss * (1.0f / 32.0f);
            const f32x4 pv = ld_nt(P.p + (size_t)row * 256 + lane * 4);
            u32x2 pw; pw.x = cvt_pk_bf16(pv[0], pv[1]); pw.y = cvt_pk_bf16(pv[2], pv[3]);
            *(u32x2*)(hb + (size_t)row * LDHB + lane * 4) = pw;
        }
    }
    {
        float* rc = (float*)(P.ws + OFF_ROPEC); float* rs = (float*)(P.ws + OFF_ROPES);
        for (int i = blockIdx.x * 512 + tid; i < 2048 * 32; i += G * 512) {
            const int pos = i >> 5, f = i & 31;
            const float invf = __builtin_amdgcn_exp2f(-13.287712379549449f * (float)f * (1.0f / 32.0f));
            const float ang = (float)pos * invf;
            const double rev = (double)ang * 0.15915494309189535; const float fr = (float)(rev - __builtin_rint(rev));
            rc[i] = __builtin_amdgcn_cosf(fr); rs[i] = __builtin_amdgcn_sinf(fr);
        }
    }
    {
        u32x4* z = (u32x4*)(P.ws + OFF_WIN + 8256ull * LDB2K * 2); const u32x4 zero = {0u, 0u, 0u, 0u};
        for (int i = blockIdx.x * 512 + tid; i < 192 * LDB2K * 2 / 16; i += G * 512) z[i] = zero;
    }
    { int cvt_base = 0; CVT_JOB(0); CVT_JOB(1); CVT_JOB(2); CVT_JOB(3); CVT_JOB(4); CVT_JOB(5); CVT_JOB(6); CVT_JOB(7); CVT_JOB(8); CVT_JOB(9); CVT_JOB(10); __syncthreads(); }
}

constexpr int BM = 256, BK = 64, HALF = 128, HTB = HALF * BK * 2, STAGE_BYTES = 8 * HTB, NXCD = 8, WGM = 8;
__device__ __forceinline__ int lds_byte(int r, int c) { const int st = (r >> 4) * 2 + (c >> 5), rr = r & 15, cc = c & 31, ob = rr * 64 + cc * 2; return st * 1024 + (ob ^ (((ob >> 9) & 1) << 5)); }
__device__ __forceinline__ void stage_rc(int b, int& R, int& C) { const int st = b / 1024, sb = b % 1024, swz = sb ^ (((sb >> 9) & 1) << 5); R = (st >> 1) * 16 + swz / 64; C = (st & 1) * 32 + (swz % 64) / 2; }
__device__ __forceinline__ int perm32(int rho) { const int n = rho >> 4, i = rho & 15; return 8 * (i >> 2) + 4 * n + (i & 3); }

struct Unit { int pm, pn, z; };
struct GSched {
    const char* A0; const char* A1; const char* B0; const char* B1;
    int nM, nN0, nN1, n0, ntot, G, c, cut;
    __device__ __forceinline__ void init(const void* a0, const void* b0, int nM_, int nN0_, const void* a1, const void* b1, int nN1_) {
        A0 = (const char*)a0; B0 = (const char*)b0; A1 = (const char*)a1; B1 = (const char*)b1; nM = nM_; nN0 = nN0_; nN1 = nN1_; n0 = nM * nN0; ntot = n0 + nM * nN1; G = gridDim.x; c = blockIdx.x; cut = 0;
    }
    __device__ __forceinline__ bool next(int i, Unit& u) const {
        long L = (long)i * G + c;
        if (cut > 0 && i >= 2) { if (c >= cut) return false; L = 2l * G + (long)(i - 2) * cut + c; }
        if (L >= ntot) return false;
        const int z = L >= n0 ? 1 : 0; int wgid = (int)L - (z ? n0 : 0); const int nN = z ? nN1 : nN0, nwg = nM * nN;
        { const int q = nwg / NXCD, r = nwg % NXCD, xcd = wgid % NXCD, off = wgid / NXCD; wgid = (xcd < r ? xcd * (q + 1) : r * (q + 1) + (xcd - r) * q) + off; }
        const int nig = WGM * nN, gid = wgid / nig, fm = gid * WGM, gsz = (nM - fm) < WGM ? (nM - fm) : WGM;
        u.pm = fm + ((wgid % nig) % gsz); u.pn = (wgid % nig) / gsz; u.z = z; return true;
    }
};

typedef f32x4 Acc[2][2][4][2];

__device__ __forceinline__ float row_rstd32(const float* part, int row, int fq) {
    const float* q = part + (size_t)row * 32 + fq * 8;
    const f32x4 a = *(const f32x4*)q, b = *(const f32x4*)(q + 4);
    float s = ((a[0] + a[1]) + (a[2] + a[3])) + ((b[0] + b[1]) + (b[2] + b[3]));
    s += __shfl_xor(s, 16); s += __shfl_xor(s, 32);
    return __builtin_amdgcn_rsqf(s * (1.0f / 2048.0f) + EPS);
}
__device__ __forceinline__ float sumsq4(const f32x4 v) { return (v[0] * v[0] + v[1] * v[1]) + (v[2] * v[2] + v[3] * v[3]); }
__device__ __forceinline__ u32x4 pack8(const f32x4 a, const f32x4 b) { u32x4 w; w.x = cvt_pk_bf16(a[0], a[1]); w.y = cvt_pk_bf16(a[2], a[3]); w.z = cvt_pk_bf16(b[0], b[1]); w.w = cvt_pk_bf16(b[2], b[3]); return w; }
__device__ __forceinline__ void unpack8(const u32x4 w, f32x4& a, f32x4& b) { a = (f32x4){bf_lo(w.x), bf_hi(w.x), bf_lo(w.y), bf_hi(w.y)}; b = (f32x4){bf_lo(w.z), bf_hi(w.z), bf_lo(w.w), bf_hi(w.w)}; }


__device__ __forceinline__ void rstd_regs32(float (&rsv)[8], const float* part, int row0, int fq) {
    int r0 = row0; asm volatile("" : "+v"(r0));
    const float* q = part + (size_t)r0 * 32 + fq * 8;
    f32x4 a[8], b[8];
#pragma unroll
    for (int g = 0; g < 8; ++g) { const float* p = q + (size_t)((g >> 2) * HALF + (g & 3) * 16) * 32; a[g] = *(const f32x4*)p; b[g] = *(const f32x4*)(p + 4); }
#pragma unroll
    for (int g = 0; g < 8; ++g) { float s = ((a[g][0] + a[g][1]) + (a[g][2] + a[g][3])) + ((b[g][0] + b[g][1]) + (b[g][2] + b[g][3]));
        s += __shfl_xor(s, 16); s += __shfl_xor(s, 32); rsv[g] = __builtin_amdgcn_rsqf(s * (1.0f / 2048.0f) + EPS); }
}
__device__ __forceinline__ void rstd_regs_lat(float (&rsv)[8], const float* latpart, int row0, int z) {
    int r0 = row0; asm volatile("" : "+v"(r0));
    const float* q = latpart + (size_t)r0 * 16 + z * 8;
    f32x4 a[8], b[8];
#pragma unroll
    for (int g = 0; g < 8; ++g) { const float* p = q + (size_t)((g >> 2) * HALF + (g & 3) * 16) * 16; a[g] = *(const f32x4*)p; b[g] = *(const f32x4*)(p + 4); }
#pragma unroll
    for (int g = 0; g < 8; ++g) { const float s = ((a[g][0] + a[g][1]) + (a[g][2] + a[g][3])) + ((b[g][0] + b[g][1]) + (b[g][2] + b[g][3]));
        rsv[g] = __builtin_amdgcn_rsqf(s * (1.0f / 512.0f) + EPS); }
}
struct EpiSwiglu {
    static constexpr bool NARROW = false; static constexpr bool HAS_MID = false; int mid_t;
    static constexpr bool RSTD = true;
    __device__ __forceinline__ void rstd_fill(float (&rsv)[8], const Unit& u, int wr, int fr, int fq) const { rstd_regs32(rsv, part, u.pm * BM + wr * 64 + fr, fq); }
    bf16_t* act; const float* part;
    __device__ __forceinline__ void mid(Acc&, const Unit&, int, int, int, int) const {}
    __device__ __forceinline__ void operator()(Acc& acc, const Unit& u, int wr, int wc, int fr, int fq, const float (&rsv)[8]) const {
        const int row0 = u.pm * BM + wr * 64 + fr, col = u.pn * 128 + wc * 32 + 8 * fq;
#pragma unroll
        for (int ai = 0; ai < 2; ++ai)
#pragma unroll
            for (int m = 0; m < 4; ++m) {
                const int row = row0 + ai * HALF + m * 16; const float rs = rsv[ai * 4 + m];
                f32x4 o[2];
                const float rsn = rs * -1.4426950408889634f, rs2 = rs * rs;
#pragma unroll
                for (int n = 0; n < 2; ++n) { const f32x4 g = acc[ai][0][m][n], uu = acc[ai][1][m][n]; const f32x4 t = g * rsn, w = (g * uu) * rs2;
#pragma unroll
                    for (int j = 0; j < 4; ++j) o[n][j] = w[j] * __builtin_amdgcn_rcpf(1.0f + __builtin_amdgcn_exp2f(t[j])); }
                st_nt(act + (size_t)row * LDACT + col, pack8(o[0], o[1]));
            }
    }
};
template <bool F32IN> struct EpiResid {
    static constexpr bool NARROW = false; static constexpr bool HAS_MID = false; int mid_t;
    static constexpr bool RSTD = false;
    __device__ __forceinline__ void rstd_fill(float (&rsv)[8], const Unit& u, int wr, int fr, int fq) const { }
    const float* hin; bf16_t* hb; float* part; float scale;
    __device__ __forceinline__ void mid(Acc&, const Unit&, int, int, int, int) const {}
    __device__ __forceinline__ void operator()(Acc& acc, const Unit& u, int wr, int wc, int fr, int fq, const float (&rsv)[8]) const {
        const int row0 = u.pm * BM + wr * 64 + fr, col0 = u.pn * BM + wc * 32 + 8 * fq;
        if constexpr (F32IN) {
            f32x4 w[4][4];
#pragma unroll
            for (int g = 0; g < 4; ++g) { const float* hp = hin + (size_t)(row0 + (g >> 2) * HALF + (g & 3) * 16) * DM + col0;
                w[g][0] = ld_nt(hp); w[g][1] = ld_nt(hp + 4); w[g][2] = ld_nt(hp + HALF); w[g][3] = ld_nt(hp + HALF + 4); }
#pragma unroll
            for (int g = 0; g < 8; ++g) {
                const int ai = g >> 2, m = g & 3, s = g & 3;
                const int row = row0 + ai * HALF + m * 16;
                float ss = 0.f;
#pragma unroll
                for (int bj = 0; bj < 2; ++bj) {
                    const f32x4 v0 = w[s][bj * 2] + acc[ai][bj][m][0] * scale, v1 = w[s][bj * 2 + 1] + acc[ai][bj][m][1] * scale;
                    ss += sumsq4(v0) + sumsq4(v1);
                    *(u32x4*)(hb + (size_t)row * LDHB + 256 + col0 + bj * HALF) = pack8(v0, v1); }
                ss += __shfl_xor(ss, 16); ss += __shfl_xor(ss, 32);
                if (fq == 0) part[(size_t)row * 32 + u.pn * 4 + wc] = ss;
                asm volatile("" ::: "memory");
                if (g + 4 < 8) { const int g4 = g + 4; const float* hp = hin + (size_t)(row0 + (g4 >> 2) * HALF + (g4 & 3) * 16) * DM + col0;
                    w[s][0] = ld_nt(hp); w[s][1] = ld_nt(hp + 4); w[s][2] = ld_nt(hp + HALF); w[s][3] = ld_nt(hp + HALF + 4); }
            }
        } else {
            u32x4 w[8][2];
#pragma unroll
            for (int g = 0; g < 8; ++g)
#pragma unroll
                for (int bj = 0; bj < 2; ++bj) w[g][bj] = *(const u32x4*)(hb + (size_t)(row0 + (g >> 2) * HALF + (g & 3) * 16) * LDHB + 256 + col0 + bj * HALF);
#pragma unroll
            for (int g = 0; g < 8; ++g) {
                const int ai = g >> 2, m = g & 3;
                const int row = row0 + ai * HALF + m * 16;
                float ss = 0.f;
#pragma unroll
                for (int bj = 0; bj < 2; ++bj) { f32x4 h0, h1; unpack8(w[g][bj], h0, h1);
                    const f32x4 v0 = h0 + acc[ai][bj][m][0] * scale, v1 = h1 + acc[ai][bj][m][1] * scale;
                    ss += sumsq4(v0) + sumsq4(v1);
                    *(u32x4*)(hb + (size_t)row * LDHB + 256 + col0 + bj * HALF) = pack8(v0, v1); }
                ss += __shfl_xor(ss, 16); ss += __shfl_xor(ss, 32);
                if (fq == 0) part[(size_t)row * 32 + u.pn * 4 + wc] = ss;
            }
        }
    }
};

struct EpiWin {
    static constexpr bool NARROW = false; static constexpr bool HAS_MID = false; int mid_t;
    static constexpr bool RSTD = true;
    __device__ __forceinline__ void rstd_fill(float (&rsv)[8], const Unit& u, int wr, int fr, int fq) const { rstd_regs32(rsv, part, u.pm * BM + wr * 64 + fr, fq); }
    bf16_t* qkv; bf16_t* lat; float* latpart; const float* part;
    __device__ __forceinline__ void mid(Acc&, const Unit&, int, int, int, int) const {}
    __device__ __forceinline__ void operator()(Acc& acc, const Unit& u, int wr, int wc, int fr, int fq, const float (&rsv)[8]) const {
        const int row0 = u.pm * BM + wr * 64 + fr, cin = wc * 32 + 8 * fq;
        const bool is_lat = u.pn >= 12;
#pragma unroll
        for (int ai = 0; ai < 2; ++ai)
#pragma unroll
            for (int m = 0; m < 4; ++m) {
                const int row = row0 + ai * HALF + m * 16; const float rs = rsv[ai * 4 + m]; float ss = 0.f;
#pragma unroll
                for (int bj = 0; bj < 2; ++bj) { const f32x4 v0 = acc[ai][bj][m][0] * rs, v1 = acc[ai][bj][m][1] * rs; ss += sumsq4(v0) + sumsq4(v1);
                    bf16_t* dst = is_lat ? lat + (size_t)row * 1024 + (u.pn - 12) * BM + cin + bj * HALF : qkv + (size_t)row * 3072 + u.pn * BM + cin + bj * HALF;
                    st_nt(dst, pack8(v0, v1)); }
                if (is_lat) { ss += __shfl_xor(ss, 16); ss += __shfl_xor(ss, 32); if (fq == 0) latpart[(size_t)row * 16 + (u.pn - 12) * 4 + wc] = ss; }
            }
    }
};
struct EpiGates {
    static constexpr bool NARROW = false; static constexpr bool HAS_MID = false; int mid_t;
    static constexpr bool RSTD = true;
    __device__ __forceinline__ void rstd_fill(float (&rsv)[8], const Unit& u, int wr, int fr, int fq) const { rstd_regs32(rsv, part, u.pm * BM + wr * 64 + fr, fq); }
    bf16_t* gates; const float* part;
    __device__ __forceinline__ void mid(Acc&, const Unit&, int, int, int, int) const {}
    __device__ __forceinline__ void operator()(Acc& acc, const Unit& u, int wr, int wc, int fr, int fq, const float (&rsv)[8]) const {
        const int row0 = u.pm * BM + wr * 64 + fr, col = u.pn * HALF + wc * 32 + 8 * fq;
#pragma unroll
        for (int ai = 0; ai < 2; ++ai)
#pragma unroll
            for (int m = 0; m < 4; ++m) {
                const int row = row0 + ai * HALF + m * 16; const float rs = rsv[ai * 4 + m];
                f32x4 r0, r1, b0, b1;
#pragma unroll
                for (int jj = 0; jj < 4; ++jj) {
                    const float rsn = rs * -1.4426950408889634f;
                    const float da0 = 1.0f + __builtin_amdgcn_exp2f(acc[ai][0][m][0][jj] * rsn), da1 = 1.0f + __builtin_amdgcn_exp2f(acc[ai][0][m][1][jj] * rsn);
                    const float db0 = 1.0f + __builtin_amdgcn_exp2f(acc[ai][1][m][0][jj] * rsn), db1 = 1.0f + __builtin_amdgcn_exp2f(acc[ai][1][m][1][jj] * rsn);
                    b0[jj] = __builtin_amdgcn_rcpf(db0); b1[jj] = __builtin_amdgcn_rcpf(db1);
                    r0[jj] = db0 * __builtin_amdgcn_rcpf(da0); r1[jj] = db1 * __builtin_amdgcn_rcpf(da1); }
                st_nt(gates + (size_t)row * 4096 + col, pack8(r0, r1));
                st_nt(gates + (size_t)row * 4096 + 2048 + col, pack8(b0, b1));
            }
    }
};
struct EpiKrope {
    static constexpr bool NARROW = true; static constexpr bool HAS_MID = false; int mid_t;
    static constexpr bool RSTD = true;
    __device__ __forceinline__ void rstd_fill(float (&rsv)[8], const Unit& u, int wr, int fr, int fq) const { rstd_regs32(rsv, part, u.pm * BM + wr * 64 + fr, fq); }
    bf16_t* krope; const float* part; const float* rc; const float* rsn;
    __device__ __forceinline__ void mid(Acc&, const Unit&, int, int, int, int) const {}
    __device__ __forceinline__ void operator()(Acc& acc, const Unit& u, int wr, int wc, int fr, int fq, const float (&rsv)[8]) const {
        if (wc >= 2) return;
        const int row0 = u.pm * BM + wr * 64 + fr, k = wc * 4 + fq;
#pragma unroll
        for (int ai = 0; ai < 2; ++ai)
#pragma unroll
            for (int m = 0; m < 4; ++m) {
                const int row = row0 + ai * HALF + m * 16; const float rs = rsv[ai * 4 + m]; const int pos = row & (SEQ - 1);
                const f32x4 c = *(const f32x4*)(rc + pos * 32 + 4 * k), s = *(const f32x4*)(rsn + pos * 32 + 4 * k);
                const f32x4 x1 = acc[ai][0][m][0] * rs, x2 = acc[ai][0][m][1] * rs;
                const f32x4 o1 = x1 * c - x2 * s, o2 = x2 * c + x1 * s;
                *(u32x4*)(krope + (size_t)row * 64 + wc * 32 + 8 * fq) = pack8(o1, o2);
            }
    }
};
struct EpiUp {
    static constexpr bool NARROW = false; static constexpr bool HAS_MID = false; int mid_t;
    static constexpr bool RSTD = true;
    __device__ __forceinline__ void rstd_fill(float (&rsv)[8], const Unit& u, int wr, int fr, int fq) const { rstd_regs_lat(rsv, latpart, u.pm * BM + wr * 64 + fr, u.z); }
    bf16_t* q; bf16_t* kv; const float* latpart; const float* rc; const float* rsn;
    __device__ __forceinline__ void mid(Acc&, const Unit&, int, int, int, int) const {}
    __device__ __forceinline__ void operator()(Acc& acc, const Unit& u, int wr, int wc, int fr, int fq, const float (&rsv)[8]) const {
        const int row0 = u.pm * BM + wr * 64 + fr, col0 = u.pn * BM + wc * 32 + 8 * fq;
        const int off0 = col0 % 192, off1 = (col0 + HALF) % 192;
        const int ropebj = (u.z == 0) ? (off0 >= 128 ? 0 : (off1 >= 128 ? 1 : -1)) : -1;
        const int kk = ((ropebj == 0 ? off0 : off1) - 128) >> 3;
        f32x4 cs[8], sn[8];
        if (ropebj >= 0) {
#pragma unroll
            for (int g = 0; g < 8; ++g) { const int pos = (row0 + (g >> 2) * HALF + (g & 3) * 16) & (SEQ - 1); cs[g] = *(const f32x4*)(rc + pos * 32 + 4 * kk); sn[g] = *(const f32x4*)(rsn + pos * 32 + 4 * kk); }
        } else {
#pragma unroll
            for (int g = 0; g < 8; ++g) { cs[g] = (f32x4){1.f, 1.f, 1.f, 1.f}; sn[g] = (f32x4){0.f, 0.f, 0.f, 0.f}; }
        }
#pragma unroll
        for (int ai = 0; ai < 2; ++ai)
#pragma unroll
            for (int m = 0; m < 4; ++m) {
                const int row = row0 + ai * HALF + m * 16;
                const float rs = rsv[ai * 4 + m];
#pragma unroll
                for (int bj = 0; bj < 2; ++bj) { const int col = col0 + bj * HALF; f32x4 v0 = acc[ai][bj][m][0] * rs, v1 = acc[ai][bj][m][1] * rs;
                    if (bj == ropebj) { const f32x4 c = cs[ai * 4 + m], s = sn[ai * 4 + m]; const f32x4 o1 = v0 * c - v1 * s, o2 = v1 * c + v0 * s; v0 = o1; v1 = o2; }
                    if (u.z == 0) st_nt(q + (size_t)row * 1536 + col, pack8(v0, v1));
                    else st_nt(kv + (size_t)row * 2048 + col, pack8(v0, v1)); }
            }
    }
};
struct EpiMerge {
    static constexpr bool NARROW = false; static constexpr bool HAS_MID = true; int mid_t;
    static constexpr bool RSTD = false;
    __device__ __forceinline__ void rstd_fill(float (&rsv)[8], const Unit& u, int wr, int fr, int fq) const { }
    bf16_t* merged; const bf16_t* gates;
    __device__ __forceinline__ void mid(Acc& acc, const Unit& u, int wr, int wc, int fr, int fq) const {
        int row0 = u.pm * BM + wr * 64 + fr; asm volatile("" : "+v"(row0));
        const bf16_t* gb = gates + (size_t)row0 * 4096 + u.pn * BM + wc * 32 + 8 * fq;
#pragma unroll
        for (int ai = 0; ai < 2; ++ai)
#pragma unroll
            for (int mp = 0; mp < 1; ++mp) {
                u32x4 ga[4][2];
#pragma unroll
                for (int mm = 0; mm < 4; ++mm)
#pragma unroll
                    for (int bj = 0; bj < 2; ++bj) { const bf16_t* g = gb + (size_t)(ai * HALF + mm * 16) * 4096 + bj * HALF; ga[mm][bj] = ld_nt(g); }
#pragma unroll
                for (int mm = 0; mm < 4; ++mm)
#pragma unroll
                    for (int bj = 0; bj < 2; ++bj) { const int m = mm; f32x4 a0, a1; unpack8(ga[mm][bj], a0, a1);
#pragma unroll
                        for (int j = 0; j < 4; ++j) { acc[ai][bj][m][0][j] *= a0[j]; acc[ai][bj][m][1][j] *= a1[j]; } }
                asm volatile("" ::: "memory"); }
    }
    __device__ __forceinline__ void operator()(Acc& acc, const Unit& u, int wr, int wc, int fr, int fq, const float (&rsv)[8]) const {
        const int row0 = u.pm * BM + wr * 64 + fr, col0 = u.pn * BM + wc * 32 + 8 * fq;
        u32x4 gs[8][2];
#pragma unroll
        for (int g = 0; g < 8; ++g)
#pragma unroll
            for (int bj = 0; bj < 2; ++bj) gs[g][bj] = ld_nt(gates + (size_t)(row0 + (g >> 2) * HALF + (g & 3) * 16) * 4096 + 2048 + col0 + bj * HALF);
#pragma unroll
        for (int g = 0; g < 8; ++g) { const int ai = g >> 2, m = g & 3; const int row = row0 + ai * HALF + m * 16;
#pragma unroll
            for (int bj = 0; bj < 2; ++bj) { f32x4 b0, b1; unpack8(gs[g][bj], b0, b1);
                st_nt(merged + (size_t)row * 2048 + col0 + bj * HALF, pack8(acc[ai][bj][m][0] * b0, acc[ai][bj][m][1] * b1)); } }
    }
};
struct EpiPl {
    static constexpr bool NARROW = false; static constexpr bool HAS_MID = true; int mid_t;
    static constexpr bool RSTD = true;
    __device__ __forceinline__ void rstd_fill(float (&rsv)[8], const Unit& u, int wr, int fr, int fq) const { rstd_regs32(rsv, part_in, u.pm * BM + wr * 64 + fr, fq); }
    bf16_t* h4b; const bf16_t* hb; bf16_t* etmp; const float* part_in; float* part_out;
    __device__ __forceinline__ void mid(Acc& acc, const Unit& u, int wr, int wc, int fr, int fq) const {
        int row0 = u.pm * BM + wr * 64 + fr; asm volatile("" : "+v"(row0));
        bf16_t* eb = etmp + (size_t)row0 * 2048 + u.pn * BM + wc * 32 + 8 * fq;
#pragma unroll
        for (int ai = 0; ai < 2; ++ai)
#pragma unroll
            for (int m = 0; m < 4; ++m) {
#pragma unroll
                for (int bj = 0; bj < 2; ++bj) { *(u32x4*)(eb + (size_t)(ai * HALF + m * 16) * 2048 + bj * HALF) = pack8(acc[ai][bj][m][0], acc[ai][bj][m][1]);
                    acc[ai][bj][m][0] = (f32x4){0.f, 0.f, 0.f, 0.f}; acc[ai][bj][m][1] = (f32x4){0.f, 0.f, 0.f, 0.f}; } }
    }
    __device__ __forceinline__ void operator()(Acc& acc, const Unit& u, int wr, int wc, int fr, int fq, const float (&rsv)[8]) const {
        const int row0 = u.pm * BM + wr * 64 + fr, col0 = u.pn * BM + wc * 32 + 8 * fq;
        u32x4 hw[4][2], ew[4][2];
#pragma unroll
        for (int g = 0; g < 4; ++g) { const int r = row0 + (g >> 2) * HALF + (g & 3) * 16;
#pragma unroll
            for (int bj = 0; bj < 2; ++bj) { hw[g][bj] = *(const u32x4*)(hb + (size_t)r * LDHB + 256 + col0 + bj * HALF); ew[g][bj] = ld_nt(etmp + (size_t)r * DM + col0 + bj * HALF); } }
#pragma unroll
        for (int g = 0; g < 8; ++g) {
            const int ai = g >> 2, m = g & 3, s = g & 3; const int row = row0 + ai * HALF + m * 16;
            const float rs = rsv[ai * 4 + m]; float ss = 0.f;
#pragma unroll
            for (int bj = 0; bj < 2; ++bj) { const size_t off = (size_t)row * DM + col0 + bj * HALF;
                f32x4 e0, e1, v0, v1; unpack8(ew[s][bj], e0, e1); unpack8(hw[s][bj], v0, v1);
#pragma unroll
                for (int jj = 0; jj < 4; ++jj) { v0[jj] += sigmoidf_(acc[ai][bj][m][0][jj] * rs) * e0[jj]; v1[jj] += sigmoidf_(acc[ai][bj][m][1][jj] * rs) * e1[jj]; }
                st_nt(h4b + off, pack8(v0, v1)); ss += sumsq4(v0) + sumsq4(v1); }
            ss += __shfl_xor(ss, 16); ss += __shfl_xor(ss, 32);
            if (fq == 0) part_out[(size_t)row * 32 + u.pn * 4 + wc] = ss;
            asm volatile("" ::: "memory");
            if (g + 4 < 8) { const int r = row0 + ((g + 4) >> 2) * HALF + ((g + 4) & 3) * 16;
#pragma unroll
                for (int bj = 0; bj < 2; ++bj) { hw[s][bj] = *(const u32x4*)(hb + (size_t)r * LDHB + 256 + col0 + bj * HALF); ew[s][bj] = ld_nt(etmp + (size_t)r * DM + col0 + bj * HALF); } }
        }
    }
};

template <class Epi>
__device__ __forceinline__ void gemm_phase(LAS unsigned char* lds, const GSched& S, const int K, const int lda, const int ldb, const Epi& E) {
    const int tid = opq_tid(), wid = __builtin_amdgcn_readfirstlane(tid >> 6), lane = tid & 63, wr = wid >> 2, wc = wid & 3, fr = lane & 15, fq = lane >> 4;
    const int nt = K / BK;
    unsigned voffA[2], voffB[2];
#pragma unroll
    for (int i = 0; i < 2; ++i) { int R, C; stage_rc(tid * 16 + i * 8192, R, C); const int Rb = (R & ~31) + perm32(R & 31);
        voffA[i] = (unsigned)(R * lda + C) * 2u; voffB[i] = (unsigned)(Rb * ldb + C) * 2u; }
    const size_t kstep = (size_t)(BK * 2);
    const size_t hstepA = (size_t)HALF * lda * 2, hstepB = (size_t)HALF * ldb * 2;
    const size_t tstepA = 2 * hstepA, tstepB = 2 * hstepB;
    const unsigned ldsw = (unsigned)wid * 1024u;
    const int aoff = lds_byte(wr * 64 + fr, fq * 8), boff = lds_byte(wc * 32 + fr, fq * 8);
#define PG8_SA(b, h) (((b) * 2 + (h)) * HTB)
#define PG8_SB(b, h) ((4 + (b) * 2 + (h)) * HTB)
#define PG8_STAGE(bufoff, gbase, voff) do { _Pragma("unroll") for (int _i = 0; _i < 2; ++_i) \
        __builtin_amdgcn_global_load_lds((const unsigned*)((const char*)(gbase) + (voff)[_i]), (LAS unsigned*)(lds + (bufoff) + ldsw + _i * 8192), 16, 0, 0); } while (0)
#define PG8_LDA(dst, b, h) do { _Pragma("unroll") for (int m = 0; m < 4; ++m) _Pragma("unroll") for (int k = 0; k < 2; ++k) dst[m][k] = *(const LAS bf16x8*)(lds + PG8_SA(b, h) + aoff + m * 2048 + k * 1024); } while (0)
#define PG8_LDB(dst, b, h) do { _Pragma("unroll") for (int n = 0; n < 2; ++n) _Pragma("unroll") for (int k = 0; k < 2; ++k) dst[n][k] = *(const LAS bf16x8*)(lds + PG8_SB(b, h) + boff + n * 2048 + k * 1024); } while (0)
#define PG8_MMA(ai, bj, At, Bt) do { __builtin_amdgcn_s_setprio(1); _Pragma("unroll") for (int m = 0; m < 4; ++m) _Pragma("unroll") for (int n = 0; n < 2; ++n) _Pragma("unroll") for (int k = 0; k < 2; ++k) \
        acc[ai][bj][m][n] = __builtin_amdgcn_mfma_f32_16x16x32_bf16(Bt[n][k], At[m][k], acc[ai][bj][m][n], 0, 0, 0); __builtin_amdgcn_s_setprio(0); } while (0)
#define PG8_WAIT_V(n) asm volatile("s_waitcnt vmcnt(" #n ")" ::: "memory")
#define PG8_WAIT_L(n) asm volatile("s_waitcnt lgkmcnt(" #n ")" ::: "memory")
#define PG8_BAR __builtin_amdgcn_s_barrier()
#define PG8_SCHED __builtin_amdgcn_sched_barrier(0)
    Unit cur, nxt; int ui = 0;
    if (!S.next(0, cur)) return;
    Acc acc;
#pragma unroll
    for (int a = 0; a < 2; ++a)
#pragma unroll
        for (int b = 0; b < 2; ++b)
#pragma unroll
            for (int m = 0; m < 4; ++m)
#pragma unroll
                for (int n = 0; n < 2; ++n) acc[a][b][m][n] = (f32x4){0.f, 0.f, 0.f, 0.f};
    bf16x8 At[4][2], B0[2][2], B1[2][2];
    const char* cA = (cur.z ? S.A1 : S.A0) + (size_t)cur.pm * tstepA; const char* cB = (cur.z ? S.B1 : S.B0) + (size_t)cur.pn * tstepB;
    float rsv[8];
#pragma unroll
    for (int g = 0; g < 8; ++g) rsv[g] = 0.f;
    PG8_STAGE(PG8_SB(0, 0), cB, voffB); PG8_STAGE(PG8_SA(0, 0), cA, voffA); PG8_STAGE(PG8_SB(0, 1), cB + hstepB, voffB); PG8_STAGE(PG8_SA(0, 1), cA + hstepA, voffA);
    if constexpr (Epi::RSTD) { PG8_SCHED; E.rstd_fill(rsv, cur, wr, fr, fq); PG8_SCHED; }
    if (wr == 1) PG8_BAR;
    PG8_WAIT_V(4); PG8_BAR;
    PG8_STAGE(PG8_SB(1, 0), cB + kstep, voffB); PG8_STAGE(PG8_SA(1, 0), cA + kstep, voffA); PG8_STAGE(PG8_SB(1, 1), cB + hstepB + kstep, voffB);
    PG8_WAIT_V(6); PG8_BAR;
    for (;;) {
        const bool has_next = S.next(ui + 1, nxt);
        const char* nA = has_next ? (nxt.z ? S.A1 : S.A0) + (size_t)nxt.pm * tstepA : cA; const char* nB = has_next ? (nxt.z ? S.B1 : S.B0) + (size_t)nxt.pn * tstepB : cB;
        for (int t = 0; t < nt; t += 2) {
            const bool last = (t == nt - 2);
            const char* a1 = cA + (size_t)(t + 1) * kstep;
            const char* a2 = last ? nA : cA + (size_t)(t + 2) * kstep; const char* b2 = last ? nB : cB + (size_t)(t + 2) * kstep;
            const char* a3 = a2 + kstep; const char* b3 = b2 + kstep;
            PG8_LDB(B0, 0, 0); PG8_SCHED; PG8_LDA(At, 0, 0); PG8_STAGE(PG8_SA(1, 1), a1 + hstepA, voffA);
            PG8_WAIT_L(8); PG8_BAR; PG8_WAIT_L(0); PG8_MMA(0, 0, At, B0); PG8_BAR; PG8_SCHED;
            if constexpr (!Epi::NARROW) PG8_LDB(B1, 0, 1); PG8_STAGE(PG8_SB(0, 0), b2, voffB);
            PG8_BAR; PG8_WAIT_L(0); if constexpr (!Epi::NARROW) PG8_MMA(0, 1, At, B1); PG8_BAR;
            PG8_LDA(At, 0, 1); PG8_STAGE(PG8_SA(0, 0), a2, voffA);
            PG8_BAR; PG8_WAIT_L(0); PG8_MMA(1, 0, At, B0); PG8_BAR; PG8_SCHED;
            PG8_STAGE(PG8_SB(0, 1), b2 + hstepB, voffB);
            PG8_WAIT_V(6); PG8_BAR; if constexpr (!Epi::NARROW) PG8_MMA(1, 1, At, B1); PG8_BAR;
            PG8_LDB(B0, 1, 0); PG8_SCHED; PG8_LDA(At, 1, 0); PG8_STAGE(PG8_SA(0, 1), a2 + hstepA, voffA);
            PG8_WAIT_L(8); PG8_BAR; PG8_WAIT_L(0); PG8_MMA(0, 0, At, B0); PG8_BAR; PG8_SCHED;
            if constexpr (!Epi::NARROW) PG8_LDB(B1, 1, 1); PG8_STAGE(PG8_SB(1, 0), b3, voffB);
            PG8_BAR; PG8_WAIT_L(0); if constexpr (!Epi::NARROW) PG8_MMA(0, 1, At, B1); PG8_BAR;
            PG8_LDA(At, 1, 1); PG8_STAGE(PG8_SA(1, 0), a3, voffA);
            PG8_BAR; PG8_WAIT_L(0); PG8_MMA(1, 0, At, B0); PG8_BAR; PG8_SCHED;
            PG8_STAGE(PG8_SB(1, 1), b3 + hstepB, voffB);
            PG8_WAIT_V(6); PG8_BAR; if constexpr (!Epi::NARROW) PG8_MMA(1, 1, At, B1); PG8_BAR;
            if constexpr (Epi::HAS_MID) { if (t + 2 == E.mid_t) { PG8_SCHED; E.mid(acc, cur, wr, wc, fr, fq); PG8_SCHED; } }
        }
        E(acc, cur, wr, wc, fr, fq, rsv);
        if (!has_next) break;
        if constexpr (Epi::RSTD) { if (nxt.pm != cur.pm || nxt.z != cur.z) { PG8_SCHED; E.rstd_fill(rsv, nxt, wr, fr, fq); PG8_SCHED; } }
#pragma unroll
        for (int a = 0; a < 2; ++a)
#pragma unroll
            for (int b = 0; b < 2; ++b)
#pragma unroll
                for (int m = 0; m < 4; ++m)
#pragma unroll
                    for (int n = 0; n < 2; ++n) acc[a][b][m][n] = (f32x4){0.f, 0.f, 0.f, 0.f};
        cur = nxt; cA = nA; cB = nB; ++ui;
    }
    PG8_WAIT_V(0);
    if (wr == 0) PG8_BAR;
    PG8_BAR;
#undef PG8_SA
#undef PG8_SB
#undef PG8_STAGE
#undef PG8_LDA
#undef PG8_LDB
#undef PG8_MMA
#undef PG8_WAIT_V
#undef PG8_WAIT_L
#undef PG8_BAR
#undef PG8_SCHED
}

constexpr int KVBLK = 64;
constexpr size_t SHM_V = KVBLK * 128 * 2, SHM_K = KVBLK * 128 * 2, SHM_K2 = KVBLK * 64 * 2;
constexpr size_t AOFF_V = 0, AOFF_K = 2 * SHM_V, AOFF_K2 = AOFF_K + 2 * SHM_K, AOFF_WS = AOFF_K2 + 2 * SHM_K2, AOFF_TBL = AOFF_WS + 8 * 64 * 4, AOFF_Q2 = AOFF_TBL + 15 * 128 * 4, ATT_LDS_END = AOFF_Q2 + 8 * 4096;
#define KSWZ(row, colB) ((row) * 256 + ((colB) ^ (((row) & 7) << 4)))
#define K2SWZ(row, colB) ((row) * 128 + ((colB) ^ (((row) & 7) << 4)))
#define SBAR() __builtin_amdgcn_sched_barrier(0)
__device__ __forceinline__ int crow(int r, int hi) { return (r & 3) + 8 * (r >> 2) + 4 * hi; }

template <int MODE> struct ACfg;
template <> struct ACfg<0> { static constexpr int ND0 = 12, LDQ = 1536, LDK = 2048, LDV = 2048, SDEPTH = 1, NLD = 5; static constexpr float SCALE = 0.07216878364870322f; };
template <> struct ACfg<1> { static constexpr int ND0 = 8, LDQ = 3072, LDK = 3072, LDV = 3072, SDEPTH = 1, NLD = 4; static constexpr float SCALE = 0.08838834764831845f; };
constexpr float ATT_THR = 8.f;

template <int MODE>
__device__ __forceinline__ void partialSM(f32x16& p0, f32x16& p1, float& m_reg, float& mn, float& alpha) {
    constexpr float SC = ACfg<MODE>::SCALE, C = SC * 1.4426950408889634f;
    float pmax = p0[0];
#pragma unroll
    for (int r = 1; r < 16; ++r) pmax = fmaxf(pmax, p0[r]);
#pragma unroll
    for (int r = 0; r < 16; ++r) pmax = fmaxf(pmax, p1[r]);
    { auto rr = __builtin_amdgcn_permlane32_swap(__float_as_uint(pmax), __float_as_uint(pmax), false, false);
      pmax = fmaxf(__uint_as_float(rr[0]), __uint_as_float(rr[1])); }
    if (__builtin_expect(__all(pmax - m_reg <= ATT_THR / SC), 1)) { mn = m_reg; alpha = 1.f; }
    else { mn = fmaxf(m_reg, pmax); alpha = __builtin_amdgcn_exp2f((m_reg - mn) * C); m_reg = mn; }
    const float mnC = -mn * C;
#pragma unroll
    for (int r = 0; r < 16; ++r) p0[r] = fmaf(p0[r], C, mnC);
#pragma unroll
    for (int r = 0; r < 16; ++r) p1[r] = fmaf(p1[r], C, mnC);
#pragma unroll
    for (int r = 0; r < 16; ++r) p0[r] = __builtin_amdgcn_exp2f(p0[r]);
}
__device__ __forceinline__ void finishSM(f32x16& p0, f32x16& p1, float alpha, float& l_reg, bf16x8& pa0, bf16x8& pa1, bf16x8& pa2, bf16x8& pa3) {
#pragma unroll
    for (int r = 0; r < 16; ++r) p1[r] = __builtin_amdgcn_exp2f(p1[r]);
    float ps = 0;
#pragma unroll
    for (int r = 0; r < 16; ++r) ps += p0[r];
#pragma unroll
    for (int r = 0; r < 16; ++r) ps += p1[r];
    { auto rr = __builtin_amdgcn_permlane32_swap(__float_as_uint(ps), __float_as_uint(ps), false, false);
      ps = __uint_as_float(rr[0]) + __uint_as_float(rr[1]); }
    l_reg = l_reg * alpha + ps;
#define PK4(P, BASE, OUT) do { unsigned a0 = cvt_pk_bf16(P[BASE + 0], P[BASE + 1]), a1 = cvt_pk_bf16(P[BASE + 2], P[BASE + 3]);   \
    unsigned b0 = cvt_pk_bf16(P[BASE + 4], P[BASE + 5]), b1 = cvt_pk_bf16(P[BASE + 6], P[BASE + 7]);                              \
    auto r0 = __builtin_amdgcn_permlane32_swap(a0, b0, false, false); auto r1 = __builtin_amdgcn_permlane32_swap(a1, b1, false, false); \
    u32x4 w = {r0[0], r1[0], r0[1], r1[1]}; OUT = *reinterpret_cast<bf16x8*>(&w); } while (0)
    PK4(p0, 0, pa0); PK4(p0, 8, pa1); PK4(p1, 0, pa2); PK4(p1, 8, pa3);
#undef PK4
}
template <int MODE>
__device__ __forceinline__ void qkt(f32x16& p0, f32x16& p1, const char* Ks, const char* K2s, const char* Q2s, const bf16x8* qr, int r32, int hi) {
#pragma unroll
    for (int r = 0; r < 16; ++r) { p0[r] = 0.f; p1[r] = 0.f; }
#pragma unroll
    for (int d0 = 0; d0 < 8; ++d0) { const int cb = (d0 * 16 + hi * 8) * 2;
        const bf16x8 b0 = *reinterpret_cast<const bf16x8*>(Ks + KSWZ(r32, cb));
        const bf16x8 b1 = *reinterpret_cast<const bf16x8*>(Ks + KSWZ(32 + r32, cb));
        p0 = __builtin_amdgcn_mfma_f32_32x32x16_bf16(b0, qr[d0], p0, 0, 0, 0);
        p1 = __builtin_amdgcn_mfma_f32_32x32x16_bf16(b1, qr[d0], p1, 0, 0, 0); }
    if constexpr (MODE == 0) {
#pragma unroll
        for (int d0 = 0; d0 < 4; ++d0) { const int cb = (d0 * 16 + hi * 8) * 2;
            const bf16x8 b0 = *reinterpret_cast<const bf16x8*>(K2s + K2SWZ(r32, cb));
            const bf16x8 b1 = *reinterpret_cast<const bf16x8*>(K2s + K2SWZ(32 + r32, cb));
            p0 = __builtin_amdgcn_mfma_f32_32x32x16_bf16(b0, qr[(MODE == 0 ? 8 : 0) + d0], p0, 0, 0, 0);
            p1 = __builtin_amdgcn_mfma_f32_32x32x16_bf16(b1, qr[(MODE == 0 ? 8 : 0) + d0], p1, 0, 0, 0); }
    }
}
__device__ __forceinline__ int v_st(int k, int c) { const int kk = (k & ~0xC) | ((k & 4) << 1) | ((k & 8) >> 1); return ((kk >> 3) * 4 + (c >> 5)) * 512 + ((kk & 7) * 32 + (c & 31)) * 2; }
__device__ __forceinline__ int v_rd_base(int lane) { return ((lane & 3) << 3) | (((lane >> 2) & 3) << 6) | (((lane >> 4) & 1) << 5) | (((lane >> 5) & 1) << 8); }
constexpr int v_rd_off(int d0, int ks, int half) { return d0 * 512 + ks * 4096 + half * 2048; }
template <int OFF> __device__ __forceinline__ s16x4 tr_read(int vb) {
    s16x4 r; asm volatile("ds_read_b64_tr_b16 %0, %1 offset:%2" : "=&v"(r) : "v"(vb), "i"(OFF) : "memory"); return r;
}
template <int D0> __device__ __forceinline__ void pv_one(f32x16& od, int vb, bf16x8 pa0, bf16x8 pa1, bf16x8 pa2, bf16x8 pa3) {
    const s16x4 l0 = tr_read<v_rd_off(D0, 0, 0)>(vb), h0 = tr_read<v_rd_off(D0, 0, 1)>(vb), l1 = tr_read<v_rd_off(D0, 1, 0)>(vb), h1 = tr_read<v_rd_off(D0, 1, 1)>(vb);
    const s16x4 l2 = tr_read<v_rd_off(D0, 2, 0)>(vb), h2 = tr_read<v_rd_off(D0, 2, 1)>(vb), l3 = tr_read<v_rd_off(D0, 3, 0)>(vb), h3 = tr_read<v_rd_off(D0, 3, 1)>(vb);
    asm volatile("s_waitcnt lgkmcnt(0)" ::: "memory"); SBAR();
#define PKV(L, H) (bf16x8){L[0], L[1], L[2], L[3], H[0], H[1], H[2], H[3]}
    od = __builtin_amdgcn_mfma_f32_32x32x16_bf16(pa0, PKV(l0, h0), od, 0, 0, 0);
    od = __builtin_amdgcn_mfma_f32_32x32x16_bf16(pa1, PKV(l1, h1), od, 0, 0, 0);
    od = __builtin_amdgcn_mfma_f32_32x32x16_bf16(pa2, PKV(l2, h2), od, 0, 0, 0);
    od = __builtin_amdgcn_mfma_f32_32x32x16_bf16(pa3, PKV(l3, h3), od, 0, 0, 0);
#undef PKV
}
__device__ __forceinline__ void pv_d0(f32x16* o, int vb, bf16x8 pa0, bf16x8 pa1, bf16x8 pa2, bf16x8 pa3) {
    pv_one<0>(o[0], vb, pa0, pa1, pa2, pa3); pv_one<1>(o[1], vb, pa0, pa1, pa2, pa3); pv_one<2>(o[2], vb, pa0, pa1, pa2, pa3); pv_one<3>(o[3], vb, pa0, pa1, pa2, pa3);
}
__device__ __forceinline__ void na_fix(f32x16& p0, f32x16& p1, const char* tbl, int tile_row, int rq, int rs_row, int tcol, unsigned mask0, unsigned mask1) {
    const bool tv = (tile_row >= rs_row) && (tile_row < rs_row + 8);
    if (tv) {
        const int dr = tile_row - rq + 7;
        const float* tb = (const float*)(tbl) + dr * 128 + tcol;
#pragma unroll
        for (int r = 0; r < 16; ++r) { const int o = (r & 3) + 8 * (r >> 2);
            const float b0 = tb[o], b1 = tb[o + 32];
            p0[r] = ((mask0 >> r) & 1u) ? p0[r] + b0 : -3e30f;
            p1[r] = ((mask1 >> r) & 1u) ? p1[r] + b1 : -3e30f; }
    } else {
#pragma unroll
        for (int r = 0; r < 16; ++r) { p0[r] = -3e30f; p1[r] = -3e30f; }
    }
}

template <int MODE>
__device__ __forceinline__ void attn_body(const bf16_t* __restrict__ Qb, const bf16_t* __restrict__ Kh, const bf16_t* __restrict__ Vh, const bf16_t* __restrict__ K2h,
                                          bf16_t* __restrict__ Ob, const int NT, const int na_lo, const int na_r0, const float* __restrict__ rpb_h, char* lds) {
    using CF = ACfg<MODE>;
    constexpr int LDQ = CF::LDQ, LDK = CF::LDK, LDV = CF::LDV, SDEPTH = CF::SDEPTH;
    const int tid = opq_tid(), wid = tid >> 6, lane = tid & 63, r32 = lane & 31, hi = lane >> 5;
    char* V_lds = lds + AOFF_V; char* K_lds = lds + AOFF_K; char* K2_lds = lds + AOFF_K2; char* tbl = lds + AOFF_TBL;
    float* ws = (float*)(lds + AOFF_WS) + wid * 64; float* li_l = ws; float* al_l = ws + 32;
    __syncthreads();
    int rq = 0, rs_row = 0, tcol = 0; unsigned mask0 = 0, mask1 = 0;
    if constexpr (MODE == 1) {
        for (int i = tid; i < 15 * 128; i += 512) { const int dr = i >> 7, t = (i & 127) - 63; const int dc = (t < -15 ? -15 : (t > 15 ? 15 : t)) + 15;
            ((float*)tbl)[i] = rpb_h[dr * 31 + dc] * (1.0f / CF::SCALE); }
        rq = na_r0 + (wid >> 1); rs_row = rq - 4 < 0 ? 0 : (rq - 4 > 24 ? 24 : rq - 4);
        const int cq = (wid & 1) * 32 + r32; const int cs = cq - 8 < 0 ? 0 : (cq - 8 > 48 ? 48 : cq - 8);
        tcol = 63 - cq + 4 * hi;
#pragma unroll
        for (int r = 0; r < 16; ++r) { const int ck = crow(r, hi);
            mask0 |= ((unsigned)(ck - cs) < 16u ? 1u : 0u) << r; mask1 |= ((unsigned)(ck + 32 - cs) < 16u ? 1u : 0u) << r; }
    }
    float m_reg = -1e30f, l_reg = 0;
    f32x16 o[4];
#pragma unroll
    for (int d = 0; d < 4; ++d)
#pragma unroll
        for (int r = 0; r < 16; ++r) o[d][r] = 0.f;
    bf16x8 qr[CF::ND0];
    const bf16_t* Qw = Qb + (long)(wid * 32 + r32) * LDQ + hi * 8;
#pragma unroll
    for (int d0 = 0; d0 < CF::ND0; ++d0) qr[d0] = *reinterpret_cast<const bf16x8*>(Qw + d0 * 16);
    char* Q2_lds = lds + AOFF_Q2 + wid * 4096;
    const int sr = tid >> 4, sc = (tid & 15) * 8, vst0 = v_st(sr, sc), vst1 = v_st(32 + sr, sc);
    const int s2r = tid >> 3, s2c = (tid & 7) * 8;
    const int vb0 = (int)(uintptr_t)V_lds + v_rd_base(lane);
    struct { bf16x8 vs0, vs1, ks0, ks1, k2; } sr_[SDEPTH];
#define TK0(tile) (MODE == 1 ? ((na_lo + (tile)) > 31 ? 31 : (na_lo + (tile))) * 64 : (tile) * KVBLK)
#define SLOAD(i, tile) do { const long k0_ = TK0(tile); sr_[i].vs0 = *reinterpret_cast<const bf16x8*>(&Vh[(k0_ + sr) * LDV + sc]); sr_[i].vs1 = *reinterpret_cast<const bf16x8*>(&Vh[(k0_ + 32 + sr) * LDV + sc]); \
    sr_[i].ks0 = *reinterpret_cast<const bf16x8*>(&Kh[(k0_ + sr) * LDK + sc]); sr_[i].ks1 = *reinterpret_cast<const bf16x8*>(&Kh[(k0_ + 32 + sr) * LDK + sc]); \
    if constexpr (MODE == 0) sr_[i].k2 = *reinterpret_cast<const bf16x8*>(&K2h[(k0_ + s2r) * 64 + s2c]); } while (0)
#define SWRITE(b, i) do { *(bf16x8*)(V_lds + (b) * SHM_V + vst0) = sr_[i].vs0; *(bf16x8*)(V_lds + (b) * SHM_V + vst1) = sr_[i].vs1; const int kc = sc * 2; \
    *(bf16x8*)(K_lds + (b) * SHM_K + KSWZ(sr, kc)) = sr_[i].ks0; *(bf16x8*)(K_lds + (b) * SHM_K + KSWZ(32 + sr, kc)) = sr_[i].ks1; \
    if constexpr (MODE == 0) *(bf16x8*)(K2_lds + (b) * SHM_K2 + K2SWZ(s2r, s2c * 2)) = sr_[i].k2; } while (0)
#define SWAIT() do { if constexpr (SDEPTH == 2) { if constexpr (MODE == 0) asm volatile("s_waitcnt vmcnt(5)" ::: "memory"); else asm volatile("s_waitcnt vmcnt(4)" ::: "memory"); } else asm volatile("s_waitcnt vmcnt(0)" ::: "memory"); } while (0)
#define RESC(a) do { if (__any((a) < 1.f)) { if (hi == 0) al_l[r32] = (a); asm volatile("s_waitcnt lgkmcnt(0)" ::: "memory"); \
    _Pragma("unroll") for (int d = 0; d < 4; ++d) _Pragma("unroll") for (int r = 0; r < 16; ++r) o[d][r] *= al_l[crow(r, hi)]; } } while (0)
#define NAFIX(P0, P1, tile) do { if constexpr (MODE == 1) na_fix(P0, P1, tbl, na_lo + (tile), rq, rs_row, tcol, mask0, mask1); } while (0)
    f32x16 pA0, pA1; float mnA, alA; bf16x8 pa0, pa1, pa2, pa3;
    SLOAD(0, 0); asm volatile("s_waitcnt vmcnt(0)" ::: "memory"); SWRITE(0, 0); __syncthreads();
    for (int j = 0; j < NT; ++j) {
        const int bsel = j & 1;
        if (j + 1 < NT) SLOAD(0, j + 1);
        SBAR();
        bool tile_on = true;
        if constexpr (MODE == 1) { const int trow = na_lo + j; tile_on = (trow >= rs_row) && (trow < rs_row + 8); }
        if (tile_on) {
            qkt<MODE>(pA0, pA1, K_lds + bsel * SHM_K, K2_lds + bsel * SHM_K2, Q2_lds, qr, r32, hi); NAFIX(pA0, pA1, j);
            partialSM<MODE>(pA0, pA1, m_reg, mnA, alA);
            RESC(alA);
            finishSM(pA0, pA1, alA, l_reg, pa0, pa1, pa2, pa3); SBAR();
            pv_d0(o, vb0 + bsel * (int)SHM_V, pa0, pa1, pa2, pa3);
        }
        if (j + 1 < NT) { asm volatile("s_waitcnt vmcnt(0)" ::: "memory"); SWRITE(bsel ^ 1, 0); }
        __syncthreads();
    }
    if (hi == 0) li_l[r32] = l_reg; asm volatile("s_waitcnt lgkmcnt(0)" ::: "memory");
    bf16_t* Ow = Ob + (long)(wid * 32) * 2048;
#pragma unroll
    for (int r = 0; r < 16; ++r) { const int orow = crow(r, hi); const float rl = __builtin_amdgcn_rcpf(li_l[orow]);
        const unsigned w01 = cvt_pk_bf16(o[0][r] * rl, o[1][r] * rl), w23 = cvt_pk_bf16(o[2][r] * rl, o[3][r] * rl);
        bf16_t* op = Ow + (long)orow * 2048 + r32;
        op[0] = (bf16_t)(w01 & 0xffffu); op[32] = (bf16_t)(w01 >> 16); op[64] = (bf16_t)(w23 & 0xffffu); op[96] = (bf16_t)(w23 >> 16); }
#undef TK0
#undef SLOAD
#undef SWRITE
#undef SWAIT
#undef RESC
#undef NAFIX
}


#define XB_TMO      128
#define XB_XCNT(j)  (256  + 64 * (j))
#define XB_XSUB(j)  (1280 + 64 * (j))
#define XB_XGEN(j)  (2304 + 64 * (j))
#define XB_TOP      3328
#define XB_TOPGEN   3392
#define XCD_BAR_WORDS 3456
#define XB_SPIN_CAP (1u << 22)
static_assert(XCD_BAR_WORDS * 4 <= SZ_BAR, "barrier words");
__device__ __forceinline__ unsigned xb_ld(unsigned* p)              { return __hip_atomic_load(p, __ATOMIC_RELAXED, __HIP_MEMORY_SCOPE_AGENT); }
__device__ __forceinline__ unsigned xb_add(unsigned* p, unsigned v) { return __hip_atomic_fetch_add(p, v, __ATOMIC_RELAXED, __HIP_MEMORY_SCOPE_AGENT); }
__device__ __forceinline__ unsigned xb_xcc_id() { return (unsigned)__builtin_amdgcn_s_getreg((3 << 11) | 20) & 0xFu; }
#define XB_SPIN(cond, bar) do { unsigned _sp = 0; while (cond) { __builtin_amdgcn_s_sleep(1); \
    if ((++_sp & 255u) == 0u) { if (xb_ld(&(bar)[XB_TMO])) break; if (_sp > XB_SPIN_CAP) { atomicAdd(&(bar)[XB_TMO], 1u); break; } } } } while (0)
struct XcdBarrier { unsigned* bar; unsigned x; volatile LAS unsigned* st; };
__device__ __forceinline__ XcdBarrier xcd_barrier_post(unsigned* bar, volatile LAS unsigned* st) {
    XcdBarrier b; b.bar = bar; b.x = xb_xcc_id(); b.st = st;
    if (threadIdx.x == 0) (void)xb_add(&bar[XB_XCNT(b.x)], 1u);
    return b;
}
__device__ __forceinline__ void xcd_barrier_complete(unsigned* bar, unsigned x, unsigned& nloc, unsigned& nx) {
    const unsigned G = gridDim.x * gridDim.y * gridDim.z;
    unsigned sum, cnt, mine, sp = 0u;
    for (;;) {
        sum = 0u; cnt = 0u; mine = 0u;
#pragma unroll
        for (unsigned j = 0; j < 16; ++j) { const unsigned c = xb_ld(&bar[XB_XCNT(j)]); sum += c; cnt += (c > 0u) ? 1u : 0u; mine = (j == x) ? c : mine; }
        if (sum == G) break;
        __builtin_amdgcn_s_sleep(1);
        if ((++sp & 255u) == 0u) { if (xb_ld(&bar[XB_TMO])) break; if (sp > XB_SPIN_CAP) { atomicAdd(&bar[XB_TMO], 1u); break; } }
    }
    nloc = mine > 0u ? mine : 1u; nx = cnt > 0u ? cnt : 1u;
}
__device__ __forceinline__ void xcd_barrier(const XcdBarrier& b) {
    asm volatile("s_waitcnt vmcnt(0)" ::: "memory");
    __syncthreads();
    if (threadIdx.x == 0) {
        unsigned* bar = b.bar;
        __builtin_amdgcn_s_waitcnt(0);
        unsigned nloc = b.st[0], nx = b.st[1];
        if (nloc == 0u) { xcd_barrier_complete(bar, b.x, nloc, nx); b.st[0] = nloc; b.st[1] = nx; }
        const unsigned old = xb_add(&bar[XB_XSUB(b.x)], 1u);
        const unsigned gen = old / nloc;
        if (old + 1u == (gen + 1u) * nloc) {
            __builtin_amdgcn_fence(__ATOMIC_RELEASE, "agent");
            asm volatile("s_waitcnt vmcnt(0)" ::: "memory");
            const unsigned og = xb_add(&bar[XB_TOP], 1u);
            const unsigned tg = og / nx;
            if (og + 1u == (tg + 1u) * nx) xb_add(&bar[XB_TOPGEN], 1u);
            else XB_SPIN(xb_ld(&bar[XB_TOPGEN]) == tg, bar);
            __builtin_amdgcn_fence(__ATOMIC_ACQUIRE, "agent");
            xb_add(&bar[XB_XGEN(b.x)], 1u);
            asm volatile("s_waitcnt vmcnt(0)" ::: "memory");
        } else {
            XB_SPIN(xb_ld(&bar[XB_XGEN(b.x)]) == gen, bar);
            __builtin_amdgcn_fence(__ATOMIC_ACQUIRE, "agent");
            asm volatile("s_waitcnt vmcnt(0)" ::: "memory");
        }
    }
    __syncthreads();
}

constexpr size_t LDS_BYTES = STAGE_BYTES + 64;
static_assert(ATT_LDS_END <= LDS_BYTES, "attention LDS");

__device__ __forceinline__ void phase1(const Params& P, char* lds) {
    GSched S; S.init(P.ws + OFF_HB + 512, P.ws + OFF_WGU, 64, 44, nullptr, nullptr, 0);
    EpiSwiglu E; E.mid_t = 0; E.act = (bf16_t*)(P.ws + OFF_ACT); E.part = (const float*)(P.ws + OFF_PART0);
    gemm_phase(( LAS unsigned char*)lds, S, 2048, LDHB, LDB2K, E);
}
__device__ __forceinline__ void phase2(const Params& P, char* lds) {
    GSched S; S.init(P.ws + OFF_ACT, P.ws + OFF_WD, 64, 8, nullptr, nullptr, 0);
    EpiResid<true> E; E.mid_t = 0; E.hin = P.x; E.hb = (bf16_t*)(P.ws + OFF_HB); E.part = (float*)(P.ws + OFF_PART0 + SZ_PART); E.scale = 0.5f;
    gemm_phase((LAS unsigned char*)lds, S, 5632, LDACT, LDWD, E);
}
__device__ __forceinline__ void phase3(const Params& P, char* lds) {
    GSched S; S.init(P.ws + OFF_HB + 512, P.ws + OFF_WIN, 64, 16, nullptr, nullptr, 0);
    EpiWin E; E.mid_t = 0; E.qkv = (bf16_t*)(P.ws + OFF_QKV); E.lat = (bf16_t*)(P.ws + OFF_LAT); E.latpart = (float*)(P.ws + OFF_LATPART); E.part = (const float*)(P.ws + OFF_PART0 + SZ_PART);
    gemm_phase((LAS unsigned char*)lds, S, 2048, LDHB, LDB2K, E);
}
__device__ __forceinline__ void phase4(const Params& P, char* lds) {
    {
        GSched S; S.init(P.ws + OFF_LAT, P.ws + OFF_WUQ, 64, 6, P.ws + OFF_LAT + 1024, P.ws + OFF_WUKV, 8);
        if (gridDim.x == 256) S.cut = 192;
        EpiUp E; E.mid_t = 0; E.q = (bf16_t*)(P.ws + OFF_Q); E.kv = (bf16_t*)(P.ws + OFF_KV); E.latpart = (const float*)(P.ws + OFF_LATPART);
        E.rc = (const float*)(P.ws + OFF_ROPEC); E.rsn = (const float*)(P.ws + OFF_ROPES);
        gemm_phase((LAS unsigned char*)lds, S, 512, 1024, 512, E);
    }
    {
        GSched S; S.init(P.ws + OFF_HB + 512, P.ws + OFF_WIN + 8192ull * LDB2K * 2, 64, 1, nullptr, nullptr, 0);
        S.c = (int)gridDim.x - 1 - (int)blockIdx.x;
        EpiKrope E; E.mid_t = 0; E.krope = (bf16_t*)(P.ws + OFF_KROPE); E.part = (const float*)(P.ws + OFF_PART0 + SZ_PART);
        E.rc = (const float*)(P.ws + OFF_ROPEC); E.rsn = (const float*)(P.ws + OFF_ROPES);
        gemm_phase((LAS unsigned char*)lds, S, 2048, LDHB, LDB2K, E);
    }
    {
        const bf16_t* qkv = (const bf16_t*)(P.ws + OFF_QKV); bf16_t* att = (bf16_t*)(P.ws + OFF_ATT);
        for (int u = blockIdx.x; u < 512; u += gridDim.x) {
            const int b = u >> 6, h = (u >> 3) & 7, r0 = (u & 7) * 4;
            const int lo = r0 - 4 < 0 ? 0 : (r0 - 4 > 24 ? 24 : r0 - 4);
            const int r3 = r0 + 3 - 4; const int hi_row = (r3 < 0 ? 0 : (r3 > 24 ? 24 : r3)) + 7;
            const int NT = hi_row - lo + 1;
            const size_t tok0 = (size_t)b * SEQ;
            attn_body<1>(qkv + (tok0 + r0 * 64) * 3072 + h * 128, qkv + tok0 * 3072 + 1024 + h * 128, qkv + tok0 * 3072 + 2048 + h * 128, nullptr,
                         att + (tok0 + r0 * 64) * 2048 + h * 128, NT, lo, r0, P.na_rpb + h * 15 * 31, lds);
        }
    }
    { int cvt_base = 0; CVT_JOB(11); CVT_JOB(12); CVT_JOB(13); __syncthreads(); }
}
__device__ __forceinline__ void phase5(const Params& P, char* lds) {
    {
        GSched S; S.init(P.ws + OFF_HB + 512, P.ws + OFF_WIN + 4096ull * LDB2K * 2, 64, 16, nullptr, nullptr, 0);
        EpiGates E; E.mid_t = 0; E.gates = (bf16_t*)(P.ws + OFF_GATES); E.part = (const float*)(P.ws + OFF_PART0 + SZ_PART);
        gemm_phase((LAS unsigned char*)lds, S, 2048, LDHB, LDB2K, E);
    }
    {
        const bf16_t* q = (const bf16_t*)(P.ws + OFF_Q); const bf16_t* kv = (const bf16_t*)(P.ws + OFF_KV); const bf16_t* kr = (const bf16_t*)(P.ws + OFF_KROPE); bf16_t* att = (bf16_t*)(P.ws + OFF_ATT);
        for (int u = blockIdx.x; u < 512; u += gridDim.x) {
            const int b = u >> 6, h = (u >> 3) & 7, qb = u & 7;
            const size_t tok0 = (size_t)b * SEQ;
            attn_body<0>(q + (tok0 + qb * 256) * 1536 + h * 192, kv + tok0 * 2048 + h * 256, kv + tok0 * 2048 + h * 256 + 128, kr + tok0 * 64,
                         att + (tok0 + qb * 256) * 2048 + 1024 + h * 128, SEQ / KVBLK, 0, 0, nullptr, lds);
        }
    }
}
__device__ __forceinline__ void phase6(const Params& P, char* lds) {
    GSched S; S.init(P.ws + OFF_ATT, P.ws + OFF_WAB, 64, 8, nullptr, nullptr, 0);
    EpiMerge E; E.mid_t = 16; E.merged = (bf16_t*)(P.ws + OFF_MERGED); E.gates = (const bf16_t*)(P.ws + OFF_GATES);
    gemm_phase((LAS unsigned char*)lds, S, 2048, 2048, LDB2K, E);
}
__device__ __forceinline__ void phase7(const Params& P, char* lds) {
    GSched S; S.init(P.ws + OFF_MERGED, P.ws + OFF_WOUT, 64, 8, nullptr, nullptr, 0);
    EpiResid<false> E; E.mid_t = 0; E.hin = nullptr; E.hb = (bf16_t*)(P.ws + OFF_HB); E.part = (float*)(P.ws + OFF_PART0 + 2 * SZ_PART); E.scale = 1.0f;
    gemm_phase((LAS unsigned char*)lds, S, 2048, 2048, LDB2K, E);
}
__device__ __forceinline__ void phase8(const Params& P, char* lds) {
    GSched S; S.init(P.ws + OFF_HB + 512, P.ws + OFF_WGU, 64, 44, nullptr, nullptr, 0);
    EpiSwiglu E; E.mid_t = 0; E.act = (bf16_t*)(P.ws + OFF_ACT); E.part = (const float*)(P.ws + OFF_PART0 + 2 * SZ_PART);
    gemm_phase((LAS unsigned char*)lds, S, 2048, LDHB, LDB2K, E);
}
__device__ __forceinline__ void phase9(const Params& P, char* lds) {
    GSched S; S.init(P.ws + OFF_ACT, P.ws + OFF_WD, 64, 8, nullptr, nullptr, 0);
    EpiResid<false> E; E.mid_t = 0; E.hin = nullptr; E.hb = (bf16_t*)(P.ws + OFF_HB); E.part = (float*)(P.ws + OFF_PART0 + 3 * SZ_PART); E.scale = 0.5f;
    gemm_phase((LAS unsigned char*)lds, S, 5632, LDACT, LDWD, E);
}
__device__ __forceinline__ void phase10(const Params& P, char* lds) {
    GSched S; S.init(P.ws + OFF_HB, P.ws + OFF_WPL, 64, 8, nullptr, nullptr, 0);
    EpiPl E; E.mid_t = 4; E.h4b = (bf16_t*)(P.ws + OFF_KV); E.hb = (const bf16_t*)(P.ws + OFF_HB); E.etmp = (bf16_t*)(P.ws + OFF_ETMP); E.part_in = (const float*)(P.ws + OFF_PART0 + 3 * SZ_PART); E.part_out = (float*)(P.ws + OFF_PART0 + 4 * SZ_PART);
    gemm_phase((LAS unsigned char*)lds, S, 2304, LDHB, 2304, E);
}
__device__ __forceinline__ void phase11(const Params& P, char* lds) {
    const int tid = opq_tid(), wid = tid >> 6, lane = tid & 63;
    const float* part = (const float*)(P.ws + OFF_PART0 + 4 * SZ_PART);
    const bf16_t* h4b = (const bf16_t*)(P.ws + OFF_KV);
    for (int row = blockIdx.x * 8 + wid; row < T; row += gridDim.x * 8) {
        float s = lane < 32 ? part[(size_t)row * 32 + lane] : 0.f;
        const bf16_t* hr = h4b + (size_t)row * DM; float* orow = P.H + (size_t)row * DM;
        u32x4 hv[4];
#pragma unroll
        for (int j = 0; j < 4; ++j) hv[j] = ld_nt(hr + j * 512 + lane * 8);
#pragma unroll
        for (int o = 16; o >= 1; o >>= 1) s += __shfl_xor(s, o);
        s = __shfl(s, 0);
        const float rs = __builtin_amdgcn_rsqf(s * (1.0f / 2048.0f) + EPS);
#pragma unroll
        for (int j = 0; j < 4; ++j) { const int c = j * 512 + lane * 8; f32x4 a, b; unpack8(hv[j], a, b);
            const f32x4 g0 = *(const f32x4*)(P.final_norm + c), g1 = *(const f32x4*)(P.final_norm + c + 4);
            st_nt(orow + c, a * rs * g0); st_nt(orow + c + 4, b * rs * g1); }
    }
}

typedef __attribute__((address_space(4))) const Params* KArgPtr;
template <int PH> __device__ __forceinline__ void run_phase(char* lds) {
#if defined(__HIP_DEVICE_COMPILE__)
    KArgPtr kp = (KArgPtr)__builtin_amdgcn_kernarg_segment_ptr(); asm volatile("" : "+s"(kp));
    const Params P = *kp;
#else
    const Params P{};
#endif
    if constexpr (PH == 0) phase0(P, lds);
    if constexpr (PH == 1) phase1(P, lds);
    if constexpr (PH == 2) phase2(P, lds);
    if constexpr (PH == 3) phase3(P, lds);
    if constexpr (PH == 4) phase4(P, lds);
    if constexpr (PH == 5) phase5(P, lds);
    if constexpr (PH == 6) phase6(P, lds);
    if constexpr (PH == 7) phase7(P, lds);
    if constexpr (PH == 8) phase8(P, lds);
    if constexpr (PH == 9) phase9(P, lds);
    if constexpr (PH == 10) phase10(P, lds);
    if constexpr (PH == 11) phase11(P, lds);
}

#if MEGA
__global__ __launch_bounds__(512, 2) void fwd_megakernel(Params P) {
    extern __shared__ __attribute__((aligned(16))) char shm[];
    cg::grid_group grid = cg::this_grid();
    volatile LAS unsigned* st = (volatile LAS unsigned*)(shm + STAGE_BYTES);
    if (threadIdx.x == 0) { st[0] = 0u; st[1] = 0u; }
    __syncthreads();
    if (blockIdx.x == 0) { unsigned* bw = (unsigned*)(P.ws + OFF_BAR); for (int i = threadIdx.x; i < XCD_BAR_WORDS; i += 512) __hip_atomic_store(bw + i, 0u, __ATOMIC_RELAXED, __HIP_MEMORY_SCOPE_AGENT); }
    run_phase<0>(shm); asm volatile("s_waitcnt vmcnt(0)" ::: "memory"); __syncthreads(); grid.sync();
    const XcdBarrier xb = xcd_barrier_post((unsigned*)(P.ws + OFF_BAR), st);
    run_phase<1>(shm); xcd_barrier(xb);
    run_phase<2>(shm); xcd_barrier(xb);
    run_phase<3>(shm); xcd_barrier(xb);
    run_phase<4>(shm); xcd_barrier(xb);
    run_phase<5>(shm); xcd_barrier(xb);
    run_phase<6>(shm); xcd_barrier(xb);
    run_phase<7>(shm); xcd_barrier(xb);
    run_phase<8>(shm); xcd_barrier(xb);
    run_phase<9>(shm); xcd_barrier(xb);
    run_phase<10>(shm); xcd_barrier(xb);
    run_phase<11>(shm);
}
#else
template <int PH> __global__ __launch_bounds__(512, 2) void k_phase(Params P) {
    extern __shared__ __attribute__((aligned(16))) char shm[];
    run_phase<PH>(shm);
}
template <int PH> static void launch_phase(const Params& P, hipStream_t stream) {
    hipFuncSetAttribute((const void*)k_phase<PH>, hipFuncAttributeMaxDynamicSharedMemorySize, (int)LDS_BYTES);
    hipLaunchKernelGGL(k_phase<PH>, dim3(256), dim3(512), LDS_BYTES, stream, P);
}
#endif

extern "C" void kernel_launch(void* const* d_in, const int* in_sizes, int n_in, void* d_out, int out_size, void* d_ws, size_t ws_size, hipStream_t stream) {
    (void)in_sizes; (void)out_size;
    if (n_in != 24 || ws_size < WS_END) { fprintf(stderr, "kernel_launch: unexpected n_in %d or ws_size %zu (need %zu)\n", n_in, ws_size, (size_t)WS_END); return; }
    Params P{};
    const float** f = (const float**)&P;
    for (int i = 0; i < 24; ++i) f[i] = (const float*)d_in[i];
    P.H = (float*)d_out; P.ws = (char*)d_ws;
#if MEGA
    static int grid_blocks = 0;
    if (!grid_blocks) {
        hipFuncSetAttribute((const void*)fwd_megakernel, hipFuncAttributeMaxDynamicSharedMemorySize, (int)LDS_BYTES);
        int dev = 0, cus = 0, per_cu = 0;
        hipGetDevice(&dev);
        hipDeviceGetAttribute(&cus, hipDeviceAttributeMultiprocessorCount, dev);
        hipOccupancyMaxActiveBlocksPerMultiprocessor(&per_cu, fwd_megakernel, 512, LDS_BYTES);
        if (per_cu < 1) per_cu = 1;
        grid_blocks = cus < 256 ? cus : 256;
    }
    void* args[] = {&P};
    hipError_t e = hipLaunchCooperativeKernel((void*)fwd_megakernel, dim3(grid_blocks), dim3(512), args, LDS_BYTES, stream);
    if (e != hipSuccess) fprintf(stderr, "cooperative launch failed: %s (grid %d)\n", hipGetErrorString(e), grid_blocks);
#else
    launch_phase<0>(P, stream); launch_phase<1>(P, stream); launch_phase<2>(P, stream); launch_phase<3>(P, stream);
    launch_phase<4>(P, stream); launch_phase<5>(P, stream); launch_phase<6>(P, stream); launch_phase<7>(P, stream);
    launch_phase<8>(P, stream); launch_phase<9>(P, stream); launch_phase<10>(P, stream); launch_phase<11>(P, stream);
#endif
}
```
